# Optimizing an MI355X kernel written in HIP

```python
import jax, jax.numpy as jnp
from jax import lax
import numpy as np

D_MODEL = 2048
BATCH = 1
SEQ = 8192
DEPTH = 2

GRID_W = 64
GM_GROUPS = 8
GM_HEAD = 128
GM_WIDTH = GM_GROUPS * GM_HEAD
CHUNK = 128
NA_HEADS = 16
NA_HEAD_DIM = 64
NA_WIDTH = NA_HEADS * NA_HEAD_DIM
NA_KR = 8
NA_KC = 16
N_BRANCH = 2
IN_COLS = 2 * GM_WIDTH + 3 * NA_WIDTH + N_BRANCH * D_MODEL
D_FF = 5504
CONV_W = 3
RMS_EPS = 1e-6
LN_EPS = 1e-5
NEG_INF = -1e30

kernel_name = "hybrid_gmlp_natten_convffn_encoder"


def rms_norm(x, g):
    xf = x.astype(jnp.float32)
    y = xf * lax.rsqrt(jnp.mean(xf * xf, axis=-1, keepdims=True) + RMS_EPS)
    return (y * g.astype(jnp.float32)).astype(x.dtype)


def gmlp_branch(uv, ln_g, ln_b, w_s, b_s):
    b, t, _ = uv.shape
    uv = jax.nn.gelu(uv)
    u, v = jnp.split(uv, 2, axis=-1)
    vf = v.astype(jnp.float32)
    mu = jnp.mean(vf, axis=-1, keepdims=True)
    var = jnp.mean(jnp.square(vf - mu), axis=-1, keepdims=True)
    v = ((vf - mu) * lax.rsqrt(var + LN_EPS) * ln_g.astype(jnp.float32)
         + ln_b.astype(jnp.float32)).astype(u.dtype)
    v = v.reshape(b, t // CHUNK, CHUNK, GM_GROUPS, GM_HEAD)
    mixed = jnp.einsum('gpq,bnqgc->bnpgc', w_s, v) + b_s.T[None, None, :, :, None]
    return u * mixed.reshape(b, t, GM_WIDTH)


def neighbourhood_attn(q, k, v, rpb):
    b, t, _ = q.shape
    rows = t // GRID_W
    kr = min(NA_KR, rows)

    def to_grid(z):
        return z.reshape(b, rows, GRID_W, NA_HEADS, NA_HEAD_DIM).transpose(0, 3, 1, 2, 4)

    qg, kg, vg = to_grid(q), to_grid(k), to_grid(v)
    r = jnp.arange(rows)
    row_start = jnp.clip(r - kr // 2, 0, rows - kr)
    row_idx = row_start[:, None] + jnp.arange(kr)[None, :]
    k_blk = kg[:, :, row_idx]
    v_blk = vg[:, :, row_idx]

    c = jnp.arange(GRID_W)
    col_start = jnp.clip(c - NA_KC // 2, 0, GRID_W - NA_KC)
    in_win = (c[None, :] >= col_start[:, None]) & (c[None, :] < col_start[:, None] + NA_KC)
    dr_i = (row_idx - r[:, None]) + (NA_KR - 1)
    dc_i = jnp.clip(c[None, :] - c[:, None], -(NA_KC - 1), NA_KC - 1) + (NA_KC - 1)
    bias = rpb.astype(jnp.float32)[:, dr_i[:, None, :, None], dc_i[None, :, None, :]]
    bias = jnp.where(in_win[None, None, :, None, :], bias, NEG_INF)

    scale = NA_HEAD_DIM ** -0.5
    s = jnp.einsum('bhrcd,bhrikd->bhrcik', qg.astype(jnp.float32),
                   k_blk.astype(jnp.float32)) * scale + bias[None]
    p = jax.nn.softmax(s.reshape(b, NA_HEADS, rows, GRID_W, kr * GRID_W), axis=-1)
    p = p.reshape(b, NA_HEADS, rows, GRID_W, kr, GRID_W)
    o = jnp.einsum('bhrcik,bhrikd->bhrcd', p, v_blk.astype(jnp.float32))
    return o.transpose(0, 2, 3, 1, 4).reshape(b, t, NA_WIDTH).astype(q.dtype)


def mixer_block(x, g_norm, w_in, ln_g, ln_b, w_s, b_s, rpb, w_branch, w_out):
    h = rms_norm(x, g_norm)
    proj = h @ w_in
    uv, qkv, gates = jnp.split(proj, [2 * GM_WIDTH, 2 * GM_WIDTH + 3 * NA_WIDTH], axis=-1)
    q, k, v = jnp.split(qkv, 3, axis=-1)
    y_a = gmlp_branch(uv, ln_g, ln_b, w_s, b_s)
    y_b = neighbourhood_attn(q, k, v, rpb)
    g_a, g_b = jnp.split(jax.nn.sigmoid(gates), 2, axis=-1)
    merged = g_a * (y_a @ w_branch[:GM_WIDTH]) + g_b * (y_b @ w_branch[GM_WIDTH:])
    return x + merged @ w_out


def conv_ffn(x, g_norm, w_up, conv_k, conv_b, w_down):
    h = rms_norm(x, g_norm)
    up = h @ w_up
    t = up.shape[1]
    pad = jnp.pad(up, ((0, 0), (1, 1), (0, 0)))
    up = (pad[:, :t] * conv_k[0] + pad[:, 1:t + 1] * conv_k[1]
          + pad[:, 2:t + 2] * conv_k[2] + conv_b)
    gate, val = jnp.split(up, 2, axis=-1)
    return x + (jax.nn.silu(gate) * val) @ w_down


def setup_inputs(seed: int = 0) -> dict:
    key = jax.random.key(seed)
    ks = jax.random.split(key, 17)
    f32 = jnp.float32
    n = lambda k, s: jax.random.normal(k, s, f32)
    return {
        "x": n(ks[0], (BATCH, SEQ, D_MODEL)),
        "norm_mix": 1.0 + 0.1 * n(ks[1], (DEPTH, D_MODEL)),
        "w_in": n(ks[2], (DEPTH, D_MODEL, IN_COLS)) * D_MODEL ** -0.5,
        "gm_ln_g": 1.0 + 0.1 * n(ks[3], (DEPTH, GM_WIDTH)),
        "gm_ln_b": 0.01 * n(ks[4], (DEPTH, GM_WIDTH)),
        "gm_w_s": n(ks[5], (DEPTH, GM_GROUPS, CHUNK, CHUNK)) * CHUNK ** -0.5,
        "gm_b_s": 1.0 + 0.1 * n(ks[6], (DEPTH, GM_GROUPS, CHUNK)),
        "na_rpb": 0.5 * n(ks[7], (DEPTH, NA_HEADS, 2 * NA_KR - 1, 2 * NA_KC - 1)),
        "w_branch": n(ks[8], (DEPTH, GM_WIDTH + NA_WIDTH, D_MODEL)) * GM_WIDTH ** -0.5,
        "w_out": n(ks[9], (DEPTH, D_MODEL, D_MODEL)) * D_MODEL ** -0.5,
        "norm_ffn": 1.0 + 0.1 * n(ks[10], (DEPTH, D_MODEL)),
        "w_up": n(ks[11], (DEPTH, D_MODEL, 2 * D_FF)) * D_MODEL ** -0.5,
        "conv_k": n(ks[12], (DEPTH, CONV_W, 2 * D_FF)) * CONV_W ** -0.5,
        "conv_b": 0.01 * n(ks[13], (DEPTH, 2 * D_FF)),
        "w_down": n(ks[14], (DEPTH, D_FF, D_MODEL)) * D_FF ** -0.5,
        "norm_final": 1.0 + 0.1 * n(ks[15], (D_MODEL,)),
    }


def reference(x, norm_mix, w_in, gm_ln_g, gm_ln_b, gm_w_s, gm_b_s, na_rpb, w_branch, w_out,
              norm_ffn, w_up, conv_k, conv_b, w_down, norm_final):
    for l in range(DEPTH):
        x = mixer_block(x, norm_mix[l], w_in[l], gm_ln_g[l], gm_ln_b[l], gm_w_s[l], gm_b_s[l],
                        na_rpb[l], w_branch[l], w_out[l])
        x = conv_ffn(x, norm_ffn[l], w_up[l], conv_k[l], conv_b[l], w_down[l])
    return rms_norm(x, norm_final)
```

```cpp
#include <hip/hip_runtime.h>
#include <hip/hip_cooperative_groups.h>
#include <cstdio>
#include <cstdint>
namespace cg = cooperative_groups;

#define LAS __attribute__((address_space(3)))
typedef unsigned short bf16_t;
typedef short bf16x8 __attribute__((ext_vector_type(8)));
typedef float f32x4 __attribute__((ext_vector_type(4)));
typedef float f32x2 __attribute__((ext_vector_type(2)));
typedef unsigned u32x4 __attribute__((ext_vector_type(4)));
typedef unsigned u32x2 __attribute__((ext_vector_type(2)));

constexpr int T = 8192, D = 2048, NIN = 9216, FF = 5504, NUP = 11008, DEPTH = 2;
constexpr float RMS_EPS = 1e-6f, LN_EPS = 1e-5f;
constexpr int NWAVES = 8;
constexpr int LDS_BYTES = 147456;
#define GSYNC() xcd_barrier(xbar)
#define GSYNC_CG() do { asm volatile("s_waitcnt vmcnt(0) lgkmcnt(0)" ::: "memory"); grid.sync(); __builtin_amdgcn_fence(__ATOMIC_ACQUIRE, "agent"); asm volatile("s_waitcnt vmcnt(0)" ::: "memory"); } while (0)

constexpr size_t MiB = 1u << 20;
constexpr size_t OFF_SSQ = 0;
constexpr size_t OFF_LNS = 256 * 1024;
constexpr size_t OFF_WSB = 1 * MiB;
constexpr size_t OFF_W = 2 * MiB;
constexpr size_t WL_IN = 0, WL_BR = 36 * MiB, WL_OUT = 44 * MiB, WL_UP = 52 * MiB, WL_DN = 95 * MiB, WL_SIZE = 117 * MiB;
constexpr size_t OFF_XB0 = 236 * MiB, OFF_XB1 = 268 * MiB, OFF_X1 = 300 * MiB, OFF_BIG = 364 * MiB;
constexpr size_t OFF_U = OFF_BIG, OFF_Q = OFF_BIG + 16 * MiB, OFF_K = OFF_BIG + 32 * MiB, OFF_VTG = OFF_BIG + 48 * MiB, OFF_VTA = OFF_BIG + 64 * MiB, OFF_G = OFF_BIG + 80 * MiB;
constexpr size_t OFF_Y = OFF_BIG + 144 * MiB, OFF_TMP = OFF_BIG + 176 * MiB, OFF_MG = OFF_BIG + 240 * MiB;
constexpr size_t OFF_UP = OFF_BIG, OFF_ACT = OFF_BIG + 172 * MiB;
constexpr size_t OFF_SSQP = OFF_BIG + 272 * MiB;
constexpr size_t OFF_LNSP = OFF_SSQP + 5 * MiB;
constexpr size_t OFF_RAW = OFF_LNSP + 1 * MiB;
constexpr size_t WS_END = OFF_RAW + 22 * MiB;

__device__ __forceinline__ unsigned cvt_pk_bf16(float lo, float hi) { unsigned r; asm volatile("v_cvt_pk_bf16_f32 %0, %1, %2" : "=v"(r) : "v"(lo), "v"(hi)); return r; }
__device__ __forceinline__ float bf_lo(unsigned w) { return __uint_as_float(w << 16); }
__device__ __forceinline__ float bf_hi(unsigned w) { return __uint_as_float(w & 0xffff0000u); }
__device__ __forceinline__ float fast_rcp(float x) { return __builtin_amdgcn_rcpf(x); }
__device__ __forceinline__ float fast_exp2(float x) { return __builtin_amdgcn_exp2f(x); }
__device__ __forceinline__ float sigmoid_f(float x) { return fast_rcp(1.0f + fast_exp2(-1.4426950409f * x)); }
__device__ __forceinline__ float gelu_tanh(float x) { const float t = x + 0.044715f * x * x * x; return x * fast_rcp(1.0f + fast_exp2(-2.3022081981f * t)); }
__device__ __forceinline__ f32x4 gelu4(f32x4 v) { return (f32x4){gelu_tanh(v[0]), gelu_tanh(v[1]), gelu_tanh(v[2]), gelu_tanh(v[3])}; }
__device__ __forceinline__ f32x4 sigm4(f32x4 v) { return (f32x4){sigmoid_f(v[0]), sigmoid_f(v[1]), sigmoid_f(v[2]), sigmoid_f(v[3])}; }
__device__ __forceinline__ unsigned gate_q4(f32x4 g) {
    const unsigned a = (unsigned)(g[0] * 255.0f + 0.5f), b = (unsigned)(g[1] * 255.0f + 0.5f), c = (unsigned)(g[2] * 255.0f + 0.5f), d = (unsigned)(g[3] * 255.0f + 0.5f);
    return a | (b << 8) | (c << 16) | (d << 24);
}
__device__ __forceinline__ f32x4 gate_d4(unsigned w) {
    return (f32x4){fmaxf((float)(w & 0xffu), 0.5f), fmaxf((float)((w >> 8) & 0xffu), 0.5f), fmaxf((float)((w >> 16) & 0xffu), 0.5f), fmaxf((float)(w >> 24), 0.5f)};
}
__device__ __forceinline__ u32x4 pack8(f32x4 a, f32x4 b) { u32x4 w; w.x = cvt_pk_bf16(a[0], a[1]); w.y = cvt_pk_bf16(a[2], a[3]); w.z = cvt_pk_bf16(b[0], b[1]); w.w = cvt_pk_bf16(b[2], b[3]); return w; }

__device__ __forceinline__ float row_rstd(const float* ssp, int row, int fq) {
    const f32x4 a = *(const f32x4*)(ssp + (size_t)row * 32 + 8 * fq), b = *(const f32x4*)(ssp + (size_t)row * 32 + 8 * fq + 4);
    float s = ((a[0] + a[1]) + (a[2] + a[3])) + ((b[0] + b[1]) + (b[2] + b[3]));
    s += __shfl_xor(s, 16); s += __shfl_xor(s, 32);
    return __builtin_amdgcn_rsqf(s * (1.0f / 2048.0f) + 1e-6f);
}

namespace pg8 {
constexpr int BM = 256, BK = 64, HALF = 128, HTB = HALF * BK * 2, STAGE_BYTES = 8 * HTB, NXCD = 8, WGM = 4;
__host__ __device__ __forceinline__ int lds_byte(int r, int c) { const int st = (r >> 4) * 2 + (c >> 5), rr = r & 15, cc = c & 31, ob = rr * 64 + cc * 2; return st * 1024 + (ob ^ (((ob >> 9) & 1) << 5)); }
__host__ __device__ __forceinline__ void stage_rc(int b, int& R, int& C) { const int st = b / 1024, sb = b % 1024, swz = sb ^ (((sb >> 9) & 1) << 5); R = (st >> 1) * 16 + swz / 64; C = (st & 1) * 32 + (swz % 64) / 2; }
__host__ __device__ __forceinline__ int perm32(int rho) { const int n = rho >> 4, i = rho & 15; return 8 * (i >> 2) + 4 * n + (i & 3); }

struct Unit { int pm, pn, kind; };

__device__ __forceinline__ bool tile_of(long L, int nM, int nN, int& pm, int& pn) {
    const int nwg = nM * nN; if (L >= nwg) return false;
    int wgid = (int)L; { const int q = nwg / NXCD, r = nwg % NXCD, xcd = wgid % NXCD, off = wgid / NXCD; wgid = (xcd < r ? xcd * (q + 1) : r * (q + 1) + (xcd - r) * q) + off; }
    const int nig = WGM * nN, gid = wgid / nig, fm = gid * WGM, gsz = (nM - fm) < WGM ? (nM - fm) : WGM;
    pm = fm + ((wgid % nig) % gsz); pn = (wgid % nig) / gsz; return true;
}

template <int MODE> struct Sched {
    static constexpr int kMode = MODE;
    const char* A; const char* B; size_t tsA, tsB; int nN, G, c;
    __device__ __forceinline__ bool next(int i, Unit& u) const {
        long L; if (MODE == 2) L = (long)(i >> 1) * G + c; else L = (long)i * G + c;
        if (!tile_of(L, 32, nN, u.pm, u.pn)) return false;
        if (MODE == 1) {
            const unsigned long long w = u.pn < 10 ? 0x01442ca2480c2040ull : (u.pn < 20 ? 0x06585d655434c1c6ull : (u.pn < 30 ? 0x07de75c4503ce6daull : 0x00000008e28604d2ull));
            u.pn = (int)((w >> (6 * (u.pn % 10))) & 63ull);
        }
        if (MODE == 1) u.kind = (u.pn >= 4 && u.pn < 8) ? 1 : ((u.pn >= 16 && u.pn < 20) ? 2 : 0);
        else if (MODE == 2) u.kind = i & 1; else u.kind = 0;
        return true;
    }
    __device__ __forceinline__ void ptrs(const Unit& u, const char*& a, const char*& b) const {
        if (MODE == 1 && u.kind != 0) { a = B + (size_t)u.pn * tsB; b = A + (size_t)u.pm * tsA; }
        else { const size_t ko = (MODE == 2) ? (size_t)u.kind * 2048 : 0; a = A + (size_t)u.pm * tsA + ko; b = B + (size_t)u.pn * tsB + ko; }
    }
};

template <class Epi, class SchedT, bool ALIGN_EPI, bool SP2>
__device__ __forceinline__ void gemm_phase(LAS unsigned char* lds, const int ldk, const int nt, const SchedT& S, const Epi& E) {
    int tid = threadIdx.x; asm volatile("" : "+v"(tid));
    const int wid = __builtin_amdgcn_readfirstlane(tid >> 6), lane = tid & 63, wr = wid >> 2, wc = wid & 3, fr = lane & 15, fq = lane >> 4;
    const int K = ldk;
    unsigned voffA[2], voffB[2];
#pragma unroll
    for (int i = 0; i < 2; ++i) { int R, C; stage_rc(tid * 16 + i * 8192, R, C); const int Rb = 2 * (R & ~31) + perm32(R & 31);
        voffA[i] = (unsigned)(R * K + C) * 2u; voffB[i] = (unsigned)(Rb * K + C) * 2u; }
    const size_t kstep = (size_t)(BK * 2);
    const size_t hstep = (size_t)HALF * K * 2;
    const size_t hstepB = (size_t)32 * K * 2;
    const unsigned ldsw = (unsigned)wid * 1024u;
    const int aoff = lds_byte(wr * 64 + fr, fq * 8), boff = lds_byte(wc * 32 + fr, fq * 8);
#define PG8_SA(b, h) (((b) * 2 + (h)) * HTB)
#define PG8_SB(b, h) ((4 + (b) * 2 + (h)) * HTB)
#define PG8_STAGE(bufoff, gbase, voff) do { _Pragma("unroll") for (int _i = 0; _i < 2; ++_i) \
        __builtin_amdgcn_global_load_lds((const __attribute__((address_space(1))) unsigned*)((const char*)(gbase) + (voff)[_i]), (LAS unsigned*)(lds + (bufoff) + ldsw + _i * 8192), 16, 0, 0); } while (0)
#define PG8_LDA(dst, b, h) do { _Pragma("unroll") for (int m = 0; m < 4; ++m) _Pragma("unroll") for (int k = 0; k < 2; ++k) dst[m][k] = *(const LAS bf16x8*)(lds + PG8_SA(b, h) + aoff + m * 2048 + k * 1024); } while (0)
#define PG8_LDB(dst, b, h) do { _Pragma("unroll") for (int n = 0; n < 2; ++n) _Pragma("unroll") for (int k = 0; k < 2; ++k) dst[n][k] = *(const LAS bf16x8*)(lds + PG8_SB(b, h) + boff + n * 2048 + k * 1024); } while (0)
#define PG8_MMA(ai, bj, At, Bt) do { __builtin_amdgcn_s_setprio(1); _Pragma("unroll") for (int m = 0; m < 4; ++m) _Pragma("unroll") for (int n = 0; n < 2; ++n) _Pragma("unroll") for (int k = 0; k < 2; ++k) \
        acc[ai][bj][m][n] = __builtin_amdgcn_mfma_f32_16x16x32_bf16(Bt[n][k], At[m][k], acc[ai][bj][m][n], 0, 0, 0); __builtin_amdgcn_s_setprio(0); } while (0)
#define PG8_WAIT_V(n) asm volatile("s_waitcnt vmcnt(" #n ")" ::: "memory")
#define PG8_WAIT_L(n) asm volatile("s_waitcnt lgkmcnt(" #n ")" ::: "memory")
#define PG8_BAR __builtin_amdgcn_s_barrier()
#define PG8_SCHED __builtin_amdgcn_sched_barrier(0)
    Unit cur, nxt; int ui = 0;
    if (!S.next(0, cur)) return;
    f32x4 acc[2][2][4][2];
#pragma unroll
    for (int a = 0; a < 2; ++a)
#pragma unroll
        for (int b = 0; b < 2; ++b)
#pragma unroll
            for (int m = 0; m < 4; ++m)
#pragma unroll
                for (int n = 0; n < 2; ++n) acc[a][b][m][n] = (f32x4){0.f, 0.f, 0.f, 0.f};
    bf16x8 At[4][2], B0[2][2], B1[2][2];
    const char* cA; const char* cB; S.ptrs(cur, cA, cB);
    if constexpr (SP2) {
        PG8_STAGE(PG8_SB(0, 0), cB, voffB); PG8_STAGE(PG8_SB(0, 1), cB + hstepB, voffB); PG8_STAGE(PG8_SA(0, 0), cA, voffA); PG8_STAGE(PG8_SA(0, 1), cA + hstep, voffA);
        if (wr == 1) PG8_BAR;
        PG8_WAIT_V(2); PG8_BAR;
        PG8_STAGE(PG8_SB(1, 0), cB + kstep, voffB); PG8_STAGE(PG8_SA(1, 0), cA + kstep, voffA); PG8_STAGE(PG8_SB(1, 1), cB + hstepB + kstep, voffB);
        PG8_WAIT_V(6); PG8_BAR;
    } else {
        PG8_STAGE(PG8_SB(0, 0), cB, voffB); PG8_STAGE(PG8_SA(0, 0), cA, voffA); PG8_STAGE(PG8_SB(0, 1), cB + hstepB, voffB); PG8_STAGE(PG8_SA(0, 1), cA + hstep, voffA);
        if (wr == 1) PG8_BAR;
        PG8_WAIT_V(4); PG8_BAR;
        PG8_STAGE(PG8_SB(1, 0), cB + kstep, voffB); PG8_STAGE(PG8_SA(1, 0), cA + kstep, voffA); PG8_STAGE(PG8_SB(1, 1), cB + hstepB + kstep, voffB);
        PG8_WAIT_V(6); PG8_BAR;
    }
    for (;;) {
        const bool has_next = S.next(ui + 1, nxt);
        const char* nA = cA; const char* nB = cB; if (has_next) S.ptrs(nxt, nA, nB);
        for (int t = 0; t < nt; t += 2) {
            const bool last = (t == nt - 2);
            const char* a1 = cA + (size_t)(t + 1) * kstep;
            const char* a2 = last ? nA : cA + (size_t)(t + 2) * kstep; const char* b2 = last ? nB : cB + (size_t)(t + 2) * kstep;
            const char* a3 = a2 + kstep; const char* b3 = b2 + kstep;
            if constexpr (SP2) {
            PG8_LDB(B0, 0, 0); PG8_LDB(B1, 0, 1); PG8_SCHED; PG8_LDA(At, 0, 0); PG8_STAGE(PG8_SA(1, 1), a1 + hstep, voffA);
            PG8_WAIT_V(8); PG8_WAIT_L(0); PG8_BAR; PG8_MMA(0, 0, At, B0); PG8_MMA(0, 1, At, B1); PG8_BAR; PG8_SCHED;
            PG8_LDA(At, 0, 1); PG8_STAGE(PG8_SB(0, 0), b2, voffB); PG8_STAGE(PG8_SB(0, 1), b2 + hstepB, voffB); PG8_STAGE(PG8_SA(0, 0), a2, voffA);
            PG8_WAIT_V(8); PG8_WAIT_L(0); PG8_BAR; PG8_MMA(1, 0, At, B0); PG8_MMA(1, 1, At, B1); PG8_BAR; PG8_SCHED;
            PG8_LDB(B0, 1, 0); PG8_LDB(B1, 1, 1); PG8_SCHED; PG8_LDA(At, 1, 0); PG8_STAGE(PG8_SA(0, 1), a2 + hstep, voffA);
            PG8_WAIT_V(8); PG8_WAIT_L(0); PG8_BAR; PG8_MMA(0, 0, At, B0); PG8_MMA(0, 1, At, B1); PG8_BAR; PG8_SCHED;
            PG8_LDA(At, 1, 1); PG8_STAGE(PG8_SB(1, 0), b3, voffB); PG8_STAGE(PG8_SB(1, 1), b3 + hstepB, voffB); PG8_STAGE(PG8_SA(1, 0), a3, voffA);
            PG8_WAIT_V(8); PG8_WAIT_L(0); PG8_BAR; PG8_MMA(1, 0, At, B0); PG8_MMA(1, 1, At, B1); PG8_BAR; PG8_SCHED;
            } else {
            PG8_LDB(B0, 0, 0); PG8_SCHED; PG8_LDA(At, 0, 0); PG8_STAGE(PG8_SA(1, 1), a1 + hstep, voffA);
            PG8_WAIT_L(8); PG8_BAR; PG8_WAIT_L(0); PG8_MMA(0, 0, At, B0); PG8_BAR; PG8_SCHED;
            PG8_LDB(B1, 0, 1); PG8_STAGE(PG8_SB(0, 0), b2, voffB);
            PG8_BAR; PG8_WAIT_L(0); PG8_MMA(0, 1, At, B1); PG8_BAR;
            PG8_LDA(At, 0, 1); PG8_STAGE(PG8_SA(0, 0), a2, voffA);
            PG8_BAR; PG8_WAIT_L(0); PG8_MMA(1, 0, At, B0); PG8_BAR; PG8_SCHED;
            PG8_STAGE(PG8_SB(0, 1), b2 + hstepB, voffB);
            PG8_WAIT_V(6); PG8_BAR; PG8_MMA(1, 1, At, B1); PG8_BAR;
            PG8_LDB(B0, 1, 0); PG8_SCHED; PG8_LDA(At, 1, 0); PG8_STAGE(PG8_SA(0, 1), a2 + hstep, voffA);
            PG8_WAIT_L(8); PG8_BAR; PG8_WAIT_L(0); PG8_MMA(0, 0, At, B0); PG8_BAR; PG8_SCHED;
            PG8_LDB(B1, 1, 1); PG8_STAGE(PG8_SB(1, 0), b3, voffB);
            PG8_BAR; PG8_WAIT_L(0); PG8_MMA(0, 1, At, B1); PG8_BAR;
            PG8_LDA(At, 1, 1); PG8_STAGE(PG8_SA(1, 0), a3, voffA);
            PG8_BAR; PG8_WAIT_L(0); PG8_MMA(1, 0, At, B0); PG8_BAR; PG8_SCHED;
            PG8_STAGE(PG8_SB(1, 1), b3 + hstepB, voffB);
            PG8_WAIT_V(6); PG8_BAR; PG8_MMA(1, 1, At, B1); PG8_BAR;
            }
        }
        if constexpr (ALIGN_EPI) { if (wr == 0) PG8_BAR; }
        E(acc, cur, wr, wc, fr, fq);
        if (!has_next) break;
        if (!(SchedT::kMode == 2 && cur.kind == 0)) {
#pragma unroll
        for (int a = 0; a < 2; ++a)
#pragma unroll
            for (int b = 0; b < 2; ++b)
#pragma unroll
                for (int m = 0; m < 4; ++m)
#pragma unroll
                    for (int n = 0; n < 2; ++n) acc[a][b][m][n] = (f32x4){0.f, 0.f, 0.f, 0.f};
        }
        cur = nxt; cA = nA; cB = nB; ++ui;
        if constexpr (ALIGN_EPI) { if (wr == 1) PG8_BAR; }
    }
    PG8_WAIT_V(0);
    if constexpr (!ALIGN_EPI) { if (wr == 0) PG8_BAR; }
    PG8_BAR;
#undef PG8_SA
#undef PG8_SB
#undef PG8_STAGE
#undef PG8_LDA
#undef PG8_LDB
#undef PG8_MMA
#undef PG8_WAIT_V
#undef PG8_WAIT_L
#undef PG8_BAR
#undef PG8_SCHED
}

struct EpiIn {
    const float* ss;
    bf16_t *U, *Q, *Kb, *Gt, *VTg, *VTa; float* lns;
    __device__ __forceinline__ void operator()(f32x4 (&acc)[2][2][4][2], const Unit& u, int wr, int wc, int fr, int fq) const {
        if (u.kind == 0) {
            const int pn = u.pn; bf16_t* base; int ldc, colt, mode;
            if (pn < 4) { base = U; ldc = 1024; colt = pn * 256; mode = 0; }
            else if (pn < 12) { base = Q; ldc = 1024; colt = (pn - 8) * 256; mode = 1; }
            else if (pn < 16) { base = Kb; ldc = 1024; colt = (pn - 12) * 256; mode = 2; }
            else { base = U; ldc = 4096; colt = (pn - 20) * 256; mode = 3; }
            const int row0 = u.pm * BM + wr * 64 + fr, col0 = colt + wc * 64 + 8 * fq;
#pragma unroll
            for (int ai = 0; ai < 2; ++ai)
#pragma unroll
                for (int m = 0; m < 4; ++m) {
                    const int row = row0 + ai * HALF + m * 16;
                    float rstd = row_rstd(ss, row, fq); if (mode == 1) rstd *= 0.125f;
                    bf16_t* rowp = base + (size_t)row * ldc + col0;
#pragma unroll
                    for (int bj = 0; bj < 2; ++bj) {
                        f32x4 v0 = acc[ai][bj][m][0] * rstd, v1 = acc[ai][bj][m][1] * rstd;
                        if (mode == 3) { u32x2 w; w.x = gate_q4(sigm4(v0)); w.y = gate_q4(sigm4(v1)); *(u32x2*)((unsigned char*)Gt + (size_t)row * 4096 + col0 + bj * 32) = w; continue; }
                        if (mode == 0) { v0 = gelu4(v0); v1 = gelu4(v1); }
                        *(u32x4*)(rowp + bj * 32) = pack8(v0, v1);
                    }
                }
        } else {
            const bool isg = (u.kind == 1);
            const int ch0 = (isg ? (u.pn - 4) : (u.pn - 16)) * 256 + wr * 64 + fr;
            const int tok0 = u.pm * BM + wc * 64 + 8 * fq;
            bf16_t* base = isg ? VTg : VTa;
#pragma unroll
            for (int bj = 0; bj < 2; ++bj) {
                const int tok = tok0 + bj * 32;
                f32x4 r0, r1;
                {
                    const float* sp = ss + (size_t)(tok + (fr & 7)) * 32 + 16 * (fr >> 3);
                    const f32x4 a = *(const f32x4*)sp, b = *(const f32x4*)(sp + 4), c = *(const f32x4*)(sp + 8), d = *(const f32x4*)(sp + 12);
                    float s = (((a[0] + a[1]) + (a[2] + a[3])) + ((b[0] + b[1]) + (b[2] + b[3]))) + (((c[0] + c[1]) + (c[2] + c[3])) + ((d[0] + d[1]) + (d[2] + d[3])));
                    s += __shfl_xor(s, 8);
                    const float rt = __builtin_amdgcn_rsqf(s * (1.0f / D) + RMS_EPS);
                    const int lb = (fq << 4);
#pragma unroll
                    for (int j = 0; j < 4; ++j) { r0[j] = __shfl(rt, lb | j); r1[j] = __shfl(rt, lb | (4 + j)); }
                }
                f32x4 s0 = {0.f, 0.f, 0.f, 0.f}, s1 = s0, q0 = s0, q1 = s0;
#pragma unroll
                for (int ai = 0; ai < 2; ++ai)
#pragma unroll
                    for (int m = 0; m < 4; ++m) {
                        const int ch = ch0 + ai * HALF + m * 16;
                        f32x4 v0 = acc[ai][bj][m][0] * r0, v1 = acc[ai][bj][m][1] * r1;
                        if (isg) { v0 = gelu4(v0); v1 = gelu4(v1); s0 += v0; s1 += v1; q0 += v0 * v0; q1 += v1 * v1; }
                        *(u32x4*)(base + (size_t)ch * T + tok) = pack8(v0, v1);
                    }
                if (isg) {
#pragma unroll
                    for (int o = 1; o < 16; o <<= 1) {
#pragma unroll
                        for (int j = 0; j < 4; ++j) { s0[j] += __shfl_xor(s0[j], o); s1[j] += __shfl_xor(s1[j], o); q0[j] += __shfl_xor(q0[j], o); q1[j] += __shfl_xor(q1[j], o); }
                    }
#pragma unroll
                    for (int j = 0; j < 4; ++j) {
                        const int pidx = (u.pn - 4) * 2 + wr;
                        if (fr == j)     *(f32x2*)(lns + ((size_t)(tok + j) * 8 + pidx) * 2) = (f32x2){s0[j], q0[j]};
                        if (fr == 4 + j) *(f32x2*)(lns + ((size_t)(tok + 4 + j) * 8 + pidx) * 2) = (f32x2){s1[j], q1[j]};
                    }
                }
            }
        }
    }
};

struct EpiBr {
    const bf16_t* Gt; bf16_t* MG;
    __device__ __forceinline__ void operator()(f32x4 (&acc)[2][2][4][2], const Unit& u, int wr, int wc, int fr, int fq) const {
        const int row0 = u.pm * BM + wr * 64 + fr, col0 = u.pn * BM + wc * 64 + 8 * fq;
#pragma unroll
        for (int ai = 0; ai < 2; ++ai)
#pragma unroll
            for (int m = 0; m < 4; ++m) {
                const int row = row0 + ai * HALF + m * 16;
#pragma unroll
                for (int bj = 0; bj < 2; ++bj) {
                    const int col = col0 + bj * 32;
                    const unsigned char* grow = (const unsigned char*)Gt + (size_t)row * 4096 + col;
                    const u32x2 gw = *(const u32x2*)(grow + 2048);
                    f32x4 g0 = gate_d4(gw.x), g1 = gate_d4(gw.y);
                    if (u.kind == 0) {
                        const u32x2 aw = *(const u32x2*)grow;
                        const f32x4 a0 = gate_d4(aw.x), a1 = gate_d4(aw.y);
#pragma unroll
                        for (int j = 0; j < 4; ++j) { g0[j] = a0[j] * fast_rcp(g0[j]); g1[j] = a1[j] * fast_rcp(g1[j]); }
                        acc[ai][bj][m][0] *= g0; acc[ai][bj][m][1] *= g1;
                    } else {
                        *(u32x4*)(MG + (size_t)row * D + col) = pack8(acc[ai][bj][m][0] * (g0 * (1.0f / 255.0f)), acc[ai][bj][m][1] * (g1 * (1.0f / 255.0f)));
                    }
                }
            }
    }
};

struct EpiRes {
    const bf16_t* xin; bf16_t* xb; float* ss;
    __device__ __forceinline__ void operator()(f32x4 (&acc)[2][2][4][2], const Unit& u, int wr, int wc, int fr, int fq) const {
        const int row0 = u.pm * BM + wr * 64 + fr, col0 = u.pn * BM + wc * 64 + 8 * fq;
#pragma unroll
        for (int ai = 0; ai < 2; ++ai)
#pragma unroll
            for (int m = 0; m < 4; ++m) {
                const int row = row0 + ai * HALF + m * 16; float sq = 0.f;
#pragma unroll
                for (int bj = 0; bj < 2; ++bj) {
                    const size_t off = (size_t)row * D + col0 + bj * 32;
                    const u32x4 xw = *(const u32x4*)(xin + off);
                    const f32x4 v0 = acc[ai][bj][m][0] + (f32x4){bf_lo(xw.x), bf_hi(xw.x), bf_lo(xw.y), bf_hi(xw.y)}, v1 = acc[ai][bj][m][1] + (f32x4){bf_lo(xw.z), bf_hi(xw.z), bf_lo(xw.w), bf_hi(xw.w)};
                    *(u32x4*)(xb + off) = pack8(v0, v1);
                    sq += (v0[0] * v0[0] + v0[1] * v0[1]) + (v0[2] * v0[2] + v0[3] * v0[3]) + (v1[0] * v1[0] + v1[1] * v1[1]) + (v1[2] * v1[2] + v1[3] * v1[3]);
                }
                sq += __shfl_xor(sq, 16); sq += __shfl_xor(sq, 32);
                if (fq == 0) ss[(size_t)row * 32 + u.pn * 4 + wc] = sq;
            }
    }
};

struct EpiUpConv {
    const float* ss; const float* ck; const float* cb; bf16_t* ACT; bf16_t* RAW;
    __device__ __forceinline__ void operator()(f32x4 (&acc)[2][2][4][2], const Unit& u, int wr, int wc, int fr, int fq) const {
        const int row0 = u.pm * BM + wr * 64 + fr;
#pragma unroll
        for (int ai = 0; ai < 2; ++ai)
#pragma unroll
            for (int m = 0; m < 4; ++m) { const float rstd = row_rstd(ss, row0 + ai * HALF + m * 16, fq);
#pragma unroll
                for (int bj = 0; bj < 2; ++bj) { acc[ai][bj][m][0] *= rstd; acc[ai][bj][m][1] *= rstd; } }
#pragma unroll
        for (int n = 0; n < 2; ++n) {
            const int j4 = u.pn * 128 + wc * 32 + 8 * fq + 4 * n;
            f32x4 kc[2][3], bc[2];
#pragma unroll
            for (int bj = 0; bj < 2; ++bj) { bc[bj] = *(const f32x4*)(cb + bj * FF + j4);
#pragma unroll
                for (int w = 0; w < 3; ++w) kc[bj][w] = *(const f32x4*)(ck + w * NUP + bj * FF + j4); }
#pragma unroll
            for (int ai = 0; ai < 2; ++ai) {
                const int grp = u.pm * 4 + ai * 2 + wr;
#pragma unroll
                for (int m = 0; m < 4; ++m) {
                    f32x4 cv[2];
#pragma unroll
                    for (int bj = 0; bj < 2; ++bj) {
                        const f32x4 cur = acc[ai][bj][m][n], lo = acc[ai][bj][m > 0 ? m - 1 : 0][n], hi = acc[ai][bj][m < 3 ? m + 1 : 3][n];
                        f32x4 pv, nv;
#pragma unroll
                        for (int idx = 0; idx < 4; ++idx) {
                            const float y = (fr == 15) ? lo[idx] : cur[idx], z = (fr == 0) ? hi[idx] : cur[idx];
                            pv[idx] = __int_as_float(__builtin_amdgcn_update_dpp(0, __float_as_int(y), 0x121, 0xf, 0xf, false));
                            nv[idx] = __int_as_float(__builtin_amdgcn_update_dpp(0, __float_as_int(z), 0x12f, 0xf, 0xf, false));
                        }
                        cv[bj] = kc[bj][0] * pv + kc[bj][1] * cur + kc[bj][2] * nv + bc[bj];
                    }
                    const int row = row0 + ai * HALF + m * 16;
                    const bool edge = (m == 0 && fr == 0) || (m == 3 && fr == 15);
                    if (!edge) { const f32x4 gt = cv[0], vl = cv[1];
                        u32x2 w; w.x = cvt_pk_bf16(gt[0] * sigmoid_f(gt[0]) * vl[0], gt[1] * sigmoid_f(gt[1]) * vl[1]); w.y = cvt_pk_bf16(gt[2] * sigmoid_f(gt[2]) * vl[2], gt[3] * sigmoid_f(gt[3]) * vl[3]);
                        *(u32x2*)(ACT + (size_t)row * FF + j4) = w; }
                    if (m == 0 && fr < 2) {
#pragma unroll
                        for (int bj = 0; bj < 2; ++bj) { const f32x4 v = acc[ai][bj][0][n]; u32x2 w; w.x = cvt_pk_bf16(v[0], v[1]); w.y = cvt_pk_bf16(v[2], v[3]); *(u32x2*)(RAW + ((size_t)(grp * 4 + fr)) * NUP + bj * FF + j4) = w; } }
                    if (m == 3 && fr >= 14) {
#pragma unroll
                        for (int bj = 0; bj < 2; ++bj) { const f32x4 v = acc[ai][bj][3][n]; u32x2 w; w.x = cvt_pk_bf16(v[0], v[1]); w.y = cvt_pk_bf16(v[2], v[3]); *(u32x2*)(RAW + ((size_t)(grp * 4 + 2 + (fr - 14))) * NUP + bj * FF + j4) = w; } }
                }
            }
        }
    }
};
}

#define XB_TMO      128
#define XB_XCNT(j)  (256  + 64 * (j))
#define XB_XSUB(j)  (1280 + 64 * (j))
#define XB_XGEN(j)  (2304 + 64 * (j))
#define XB_TOP      3328
#define XB_TOPGEN   3392
#define XCD_BAR_WORDS 3456
#define XB_SPIN_CAP (1u << 18)

__device__ __forceinline__ unsigned xb_ld(unsigned* p)              { return __hip_atomic_load(p, __ATOMIC_RELAXED, __HIP_MEMORY_SCOPE_AGENT); }
__device__ __forceinline__ unsigned xb_add(unsigned* p, unsigned v) { return __hip_atomic_fetch_add(p, v, __ATOMIC_RELAXED, __HIP_MEMORY_SCOPE_AGENT); }
__device__ __forceinline__ unsigned xb_xcc_id() { return (unsigned)__builtin_amdgcn_s_getreg((3 << 11) | 20) & 0xFu; }
#define XB_SPIN(cond, bar) do { unsigned _sp = 0; while (cond) { __builtin_amdgcn_s_sleep(1); \
    if ((++_sp & 255u) == 0u) { if (xb_ld(&(bar)[XB_TMO])) break; if (_sp > XB_SPIN_CAP) { atomicAdd(&(bar)[XB_TMO], 1u); break; } } } } while (0)

struct XcdBarrier {
    unsigned* bar; unsigned x;
    volatile LAS unsigned* st;
};

__device__ __forceinline__ XcdBarrier xcd_barrier_post(unsigned* bar, volatile LAS unsigned* st) {
    XcdBarrier b; b.bar = bar; b.x = xb_xcc_id(); b.st = st;
    if (threadIdx.x == 0) (void)xb_add(&bar[XB_XCNT(b.x)], 1u);
    return b;
}
__device__ __forceinline__ void xcd_barrier_complete(unsigned* bar, unsigned x, unsigned& nloc, unsigned& nx) {
    const unsigned G = gridDim.x * gridDim.y * gridDim.z;
    unsigned sum, cnt, mine, sp = 0u;
    for (;;) {
        sum = 0u; cnt = 0u; mine = 0u;
#pragma unroll
        for (unsigned j = 0; j < 16; ++j) { const unsigned c = xb_ld(&bar[XB_XCNT(j)]); sum += c; cnt += (c > 0u) ? 1u : 0u; mine = (j == x) ? c : mine; }
        if (sum == G) break;
        __builtin_amdgcn_s_sleep(1);
        if ((++sp & 255u) == 0u) { if (xb_ld(&bar[XB_TMO])) break; if (sp > XB_SPIN_CAP) { atomicAdd(&bar[XB_TMO], 1u); break; } }
    }
    nloc = mine > 0u ? mine : 1u; nx = cnt > 0u ? cnt : 1u;
}

__device__ __forceinline__ void xcd_barrier(const XcdBarrier& b) {
    asm volatile("s_waitcnt vmcnt(0)" ::: "memory");
    __syncthreads();
    if (threadIdx.x == 0) {
        unsigned* bar = b.bar;
        __builtin_amdgcn_s_waitcnt(0);
        unsigned nloc = b.st[0], nx = b.st[1];
        if (nloc == 0u) { xcd_barrier_complete(bar, b.x, nloc, nx); b.st[0] = nloc; b.st[1] = nx; }
        const unsigned old = xb_add(&bar[XB_XSUB(b.x)], 1u);
        const unsigned gen = old / nloc;
        if (old + 1u == (gen + 1u) * nloc) {
            __builtin_amdgcn_fence(__ATOMIC_RELEASE, "agent");
            asm volatile("s_waitcnt vmcnt(0)" ::: "memory");
            const unsigned og = xb_add(&bar[XB_TOP], 1u);
            const unsigned tg = og / nx;
            if (og + 1u == (tg + 1u) * nx) xb_add(&bar[XB_TOPGEN], 1u);
            else XB_SPIN(xb_ld(&bar[XB_TOPGEN]) == tg, bar);
            __builtin_amdgcn_fence(__ATOMIC_ACQUIRE, "agent");
            xb_add(&bar[XB_XGEN(b.x)], 1u);
            asm volatile("s_waitcnt vmcnt(0)" ::: "memory");
        } else {
            XB_SPIN(xb_ld(&bar[XB_XGEN(b.x)]) == gen, bar);
            __builtin_amdgcn_fence(__ATOMIC_ACQUIRE, "agent");
            asm volatile("s_waitcnt vmcnt(0)" ::: "memory");
        }
    }
    __syncthreads();
}


__device__ __forceinline__ float wave_sum(float v) {
#pragma unroll
    for (int o = 1; o < 64; o <<= 1) v += __shfl_xor(v, o);
    return v;
}
template <bool UPPERM> __device__ __forceinline__ void p0_transpose_item(const float* W, int K, int N, bf16_t* WT, const float* gk, LAS float* scr, int item, int lane) {
    const int nblk = N / 64, kb = item / nblk, nb = item % nblk, k0 = 64 * kb, n0 = 64 * nb;
    const int dn0 = !UPPERM ? n0 : (n0 < FF ? ((n0 >> 7) * 256 + 2 * (n0 & 127)) : ((((n0 - FF) >> 7) * 256) + 2 * ((n0 - FF) & 127) + 32));
    const int r4 = lane >> 4, c4 = (lane & 15) * 4;
    f32x4 v[16];
#pragma unroll
    for (int i = 0; i < 16; ++i) v[i] = *(const f32x4*)(W + (size_t)(k0 + 4 * i + r4) * N + n0 + c4);
    if (gk) {
#pragma unroll
        for (int i = 0; i < 16; ++i) v[i] *= gk[k0 + 4 * i + r4];
    }
#pragma unroll
    for (int i = 0; i < 16; ++i) { LAS float* d = scr + (4 * i + r4) * 65 + c4; d[0] = v[i][0]; d[1] = v[i][1]; d[2] = v[i][2]; d[3] = v[i][3]; }
    asm volatile("s_waitcnt lgkmcnt(0)" ::: "memory");
    const int c = lane & 7;
#pragma unroll
    for (int j = 0; j < 8; ++j) { const int n = (lane >> 3) + 8 * j; const LAS float* s = scr + (8 * c) * 65 + n;
        u32x4 o; o.x = cvt_pk_bf16(s[0 * 65], s[1 * 65]); o.y = cvt_pk_bf16(s[2 * 65], s[3 * 65]); o.z = cvt_pk_bf16(s[4 * 65], s[5 * 65]); o.w = cvt_pk_bf16(s[6 * 65], s[7 * 65]);
        *(u32x4*)(WT + (size_t)(dn0 + (UPPERM ? ((n >> 5) * 64 + (n & 31)) : n)) * K + k0 + 8 * c) = o; }
    asm volatile("s_waitcnt lgkmcnt(0)" ::: "memory");
}

struct Params { const float* in[16]; float* out; unsigned char* ws; };

constexpr int I_IN = (D / 64) * (NIN / 64), I_BR = (D / 64) * (D / 64), I_OUT = I_BR, I_UP = (D / 64) * (NUP / 64), I_DN = (FF / 64) * (D / 64);
constexpr int I_L = I_IN + I_BR + I_OUT + I_UP + I_DN;
constexpr int CV_P0 = 8000, CV_A = 14144, CV_B = I_L + I_IN + I_BR + I_OUT, CV_C = 2 * I_L - I_DN;
static_assert(CV_P0 >= I_IN + I_BR + I_OUT && CV_P0 <= CV_A && CV_A <= I_L + I_IN && CV_A >= I_IN + I_BR + I_OUT && CV_B == I_L + I_IN + I_BR + I_OUT && CV_C == I_L + I_IN + I_BR + I_OUT + I_UP, "conversion plan");
__device__ __forceinline__ void convert_range(const Params& p, LAS unsigned char* lds, int lo, int hi, int widx, int nw, int wave, int lane) {
    LAS float* scr = (LAS float*)(lds + wave * 16640);
    for (int it = lo + widx; it < hi; it += nw) {
        const int l = it / I_L; int r = it % I_L; unsigned char* wl = p.ws + OFF_W + (size_t)l * WL_SIZE;
        const float* W; int K, N; bf16_t* WT; const float* gk = nullptr; bool upp = false;
        if (r < I_IN) { W = p.in[2] + (size_t)l * D * NIN; K = D; N = NIN; WT = (bf16_t*)(wl + WL_IN); gk = p.in[1] + l * D; }
        else if ((r -= I_IN) < I_BR) { W = p.in[8] + (size_t)l * D * D; K = D; N = D; WT = (bf16_t*)(wl + WL_BR); }
        else if ((r -= I_BR) < I_OUT) { W = p.in[9] + (size_t)l * D * D; K = D; N = D; WT = (bf16_t*)(wl + WL_OUT); }
        else if ((r -= I_OUT) < I_UP) { W = p.in[11] + (size_t)l * D * NUP; K = D; N = NUP; WT = (bf16_t*)(wl + WL_UP); gk = p.in[10] + l * D; upp = true; }
        else { r -= I_UP; W = p.in[14] + (size_t)l * FF * D; K = FF; N = D; WT = (bf16_t*)(wl + WL_DN); }
        if (upp) p0_transpose_item<true>(W, K, N, WT, gk, scr, r, lane); else p0_transpose_item<false>(W, K, N, WT, gk, scr, r, lane);
    }
}
__device__ __forceinline__ void idle_workers(int nwg, int G, int c, int& idx, int& cnt) {
    const int rounds = (nwg + G - 1) / G, full = nwg - (rounds - 1) * G;
    if (full >= G) { idx = c; cnt = G; } else { idx = c - full; cnt = G - full; }
}

__device__ __forceinline__ void p0_prologue(const Params& p, LAS unsigned char* lds, int gw, int NGW, int wave, int lane) {
    unsigned char* ws = p.ws;
    { const float* wsrc = p.in[5]; bf16_t* wsb = (bf16_t*)(ws + OFF_WSB); const int gt = gw * 64 + lane, NT = NGW * 64;
      for (int i = gt; i < DEPTH * 8 * 128 * 128 / 2; i += NT) { const f32x2 v = *(const f32x2*)(wsrc + 2 * i); ((unsigned*)wsb)[i] = cvt_pk_bf16(v.x, v.y); } }
    { const float* x = p.in[0]; bf16_t* xb = (bf16_t*)(ws + OFF_XB0); float* ssq = (float*)(ws + OFF_SSQP);
      for (int m = gw; m < T; m += 2 * NGW) {
          const int m2 = m + NGW; const bool two = m2 < T; const int mb = two ? m2 : m;
          const f32x4* xa = (const f32x4*)(x + (size_t)m * D) + lane; const f32x4* xc = (const f32x4*)(x + (size_t)mb * D) + lane;
          f32x4 va[8], vc[8];
#pragma unroll
          for (int j = 0; j < 8; ++j) va[j] = xa[64 * j];
#pragma unroll
          for (int j = 0; j < 8; ++j) vc[j] = xc[64 * j];
          { u32x2* o = (u32x2*)(xb + (size_t)m * D) + lane; float s = 0.f;
#pragma unroll
            for (int j = 0; j < 8; ++j) { const f32x4 v = va[j]; s += (v[0] * v[0] + v[1] * v[1]) + (v[2] * v[2] + v[3] * v[3]); u32x2 w; w.x = cvt_pk_bf16(v[0], v[1]); w.y = cvt_pk_bf16(v[2], v[3]); o[64 * j] = w; }
            s = wave_sum(s); if (lane < 32) ssq[(size_t)m * 32 + lane] = (lane == 0) ? s : 0.f; }
          if (two) { u32x2* o = (u32x2*)(xb + (size_t)m2 * D) + lane; float s = 0.f;
#pragma unroll
            for (int j = 0; j < 8; ++j) { const f32x4 v = vc[j]; s += (v[0] * v[0] + v[1] * v[1]) + (v[2] * v[2] + v[3] * v[3]); u32x2 w; w.x = cvt_pk_bf16(v[0], v[1]); w.y = cvt_pk_bf16(v[2], v[3]); o[64 * j] = w; }
            s = wave_sum(s); if (lane < 32) ssq[(size_t)m2 * 32 + lane] = (lane == 0) ? s : 0.f; } } }
    convert_range(p, lds, 0, CV_P0, gw, NGW, wave, lane);
}

#define MFMA16(a, b, c) __builtin_amdgcn_mfma_f32_16x16x32_bf16((a), (b), (c), 0, 0, 0)

#define SCHED_FENCE() __builtin_amdgcn_sched_barrier(0)
__device__ __forceinline__ int att_fk(int key) { return ((key >> 3) & 3) + 4 * ((key >> 1) & 1); }
__device__ __forceinline__ int att_fv(int dh) { return (dh >> 1) & 7; }
__device__ __forceinline__ void attn_phase(const bf16_t* Q, const bf16_t* Kb, const bf16_t* VTa, const float* rpb, bf16_t* Y, LAS unsigned char* lds, int bx, int G, int tid, int wave, int lane) {
    const int g = wave & 3, hf = wave >> 2;
    const int fr = lane & 15, fq = lane >> 4;
    const int cs = (g == 0) ? 0 : ((g == 1) ? 8 : ((g == 2) ? 24 : 32));
    const int c = 16 * g + fr;
    const int colstart = min(max(c - 8, 0), 48);
    const int kc0 = cs + 8 * fq;
    const int dci0 = kc0 - c + 15;
    const int wlo = max(colstart - kc0, 0), wwd = max(min(colstart + 16 - kc0, 8) - wlo, 0);
    LAS unsigned char* KL = lds; LAS unsigned char* VL = lds + 65536; LAS float* rl = (LAS float*)(lds + 131072);
    const int lr = lane >> 3, lc = lane & 7;
#define ATT_K_PIECE(h_, row_, kg_) do { const int key = (kg_) * 8 + lr; \
        __builtin_amdgcn_global_load_lds((const __attribute__((address_space(1))) unsigned*)(Kb + ((size_t)(row_) * 64 + key) * 1024 + (h_) * 64 + 8 * (lc ^ att_fk(key))), (LAS unsigned*)(KL + ((row_) & 7) * 8192 + (kg_) * 1024), 16, 0, 0); } while (0)
#define ATT_V_PIECE(h_, row_, dg_) do { const int dh = (dg_) * 8 + lr; \
        __builtin_amdgcn_global_load_lds((const __attribute__((address_space(1))) unsigned*)(VTa + (size_t)((h_) * 64 + dh) * T + (size_t)(row_) * 64 + 8 * (lc ^ att_fv(dh))), (LAS unsigned*)(VL + ((row_) & 7) * 8192 + (dg_) * 1024), 16, 0, 0); } while (0)
#define ATT_BAR() do { asm volatile("s_waitcnt lgkmcnt(0)" ::: "memory"); __builtin_amdgcn_s_barrier(); asm volatile("" ::: "memory"); } while (0)
    for (int bu = bx; bu < 256; bu += G) {
        const int h = bu & 15, r0 = (bu >> 4) * 8;
        {
            const int rs0 = min(max(r0 - 4, 0), 120);
#pragma unroll
            for (int pc = 0; pc < 8; ++pc) { ATT_K_PIECE(h, rs0 + wave, pc); ATT_V_PIECE(h, rs0 + wave, pc); }
            rl[tid] = (tid < 465) ? rpb[h * 465 + min(tid, 464)] : -1.0e30f;
        }
        bf16x8 qf0, qf1;
        { const bf16_t* qp = Q + (size_t)(r0 * 64 + c) * 1024 + h * 64 + 8 * fq; qf0 = *(const bf16x8*)qp; qf1 = *(const bf16x8*)(qp + 32); }
        asm volatile("s_waitcnt vmcnt(0)" ::: "memory");
        ATT_BAR();
        for (int n = 0; n < 8; ++n) {
            const int r = r0 + n, rs = min(max(r - 4, 0), 120);
            const bool has_next = n < 7; const int rsn = min(max(r + 1 - 4, 0), 120); const bool newrow = has_next && (rsn != rs);
            asm volatile("s_waitcnt vmcnt(1)" ::: "memory");
            ATT_BAR();
            f32x4 s[4][2];
            float mx = -3.0e38f;
#pragma unroll
            for (int ii = 0; ii < 4; ++ii) {
                const int i = 4 * hf + ii, dr = rs + i - r + 7;
                float bia[8];
#pragma unroll
                for (int j = 0; j < 8; ++j) bia[j] = rl[((unsigned)(j - wlo) < (unsigned)wwd) ? dr * 31 + dci0 + j : 480];
#pragma unroll
                for (int ta = 0; ta < 2; ++ta) {
                    const int key = cs + 8 * (fr >> 2) + 4 * ta + (fr & 3), fk = att_fk(key);
                    const LAS unsigned char* kp = KL + ((rs + i) & 7) * 8192 + key * 128;
                    const bf16x8 kf0 = *(const LAS bf16x8*)(kp + ((fq ^ fk) << 4)), kf1 = *(const LAS bf16x8*)(kp + (((4 + fq) ^ fk) << 4));
                    f32x4 a = {0.f, 0.f, 0.f, 0.f};
                    a = MFMA16(kf0, qf0, a); a = MFMA16(kf1, qf1, a);
#pragma unroll
                    for (int idx = 0; idx < 4; ++idx) { a[idx] += bia[4 * ta + idx]; mx = fmaxf(mx, a[idx]); }
                    s[ii][ta] = a;
                }
            }
            ATT_BAR();
            SCHED_FENCE();
            if (newrow) ATT_K_PIECE(h, rs + 8, wave);
            SCHED_FENCE();
            if (has_next) { const bf16_t* qp = Q + (size_t)((r + 1) * 64 + c) * 1024 + h * 64 + 8 * fq; qf0 = *(const bf16x8*)qp; qf1 = *(const bf16x8*)(qp + 32); }
            SCHED_FENCE();
            mx = fmaxf(mx, __shfl_xor(mx, 16)); mx = fmaxf(mx, __shfl_xor(mx, 32));
            float l = 0.f;
            bf16x8 pb[4];
#pragma unroll
            for (int ii = 0; ii < 4; ++ii) {
                f32x4 p0, p1;
#pragma unroll
                for (int idx = 0; idx < 4; ++idx) { p0[idx] = fast_exp2((s[ii][0][idx] - mx) * 1.4426950409f); p1[idx] = fast_exp2((s[ii][1][idx] - mx) * 1.4426950409f); }
                l += (p0[0] + p0[1]) + (p0[2] + p0[3]) + (p1[0] + p1[1]) + (p1[2] + p1[3]);
                const u32x4 pw = pack8(p0, p1); pb[ii] = __builtin_bit_cast(bf16x8, pw);
            }
            l += __shfl_xor(l, 16); l += __shfl_xor(l, 32);
            SCHED_FENCE();
            if (newrow) asm volatile("s_waitcnt vmcnt(3)" ::: "memory"); else if (has_next) asm volatile("s_waitcnt vmcnt(2)" ::: "memory"); else asm volatile("s_waitcnt vmcnt(0)" ::: "memory");
            ATT_BAR();
            f32x4 o[4];
#pragma unroll
            for (int dt = 0; dt < 4; ++dt) o[dt] = (f32x4){0.f, 0.f, 0.f, 0.f};
#pragma unroll
            for (int ii = 0; ii < 4; ++ii) {
                const int i = 4 * hf + ii;
#pragma unroll
                for (int dt = 0; dt < 4; ++dt) { const int dh = 16 * dt + fr;
                    const bf16x8 vf = *(const LAS bf16x8*)(VL + ((rs + i) & 7) * 8192 + dh * 128 + ((((cs >> 3) + fq) ^ att_fv(dh)) << 4));
                    o[dt] = MFMA16(vf, pb[ii], o[dt]); }
            }
            LAS float* ml = (LAS float*)(lds + 131072 + 2048) + (size_t)(g * 64 + lane) * 2;
            LAS u32x2* ol = (LAS u32x2*)(lds + 131072 + 4096) + (size_t)(g * 64 + lane) * 4;
            if (hf == 1) {
#pragma unroll
                for (int dt = 0; dt < 4; ++dt) { u32x2 w; w.x = cvt_pk_bf16(o[dt][0], o[dt][1]); w.y = cvt_pk_bf16(o[dt][2], o[dt][3]); ol[dt] = w; }
                ml[0] = mx; ml[1] = l;
            }
            ATT_BAR();
            if (hf == 0) {
                const float m1 = ml[0], l1 = ml[1];
                const float m = fmaxf(mx, m1), sc0 = fast_exp2((mx - m) * 1.4426950409f), sc1 = fast_exp2((m1 - m) * 1.4426950409f);
                const float inv = 1.0f / (l * sc0 + l1 * sc1);
                bf16_t* yp = Y + (size_t)(r * 64 + c) * 2048 + 1024 + h * 64 + 4 * fq;
#pragma unroll
                for (int dt = 0; dt < 4; ++dt) { const u32x2 pw = ol[dt]; const f32x4 o1 = {bf_lo(pw.x), bf_hi(pw.x), bf_lo(pw.y), bf_hi(pw.y)}; const f32x4 v = (o[dt] * sc0 + o1 * sc1) * inv;
                    u32x2 w; w.x = cvt_pk_bf16(v[0], v[1]); w.y = cvt_pk_bf16(v[2], v[3]); *(u32x2*)(yp + 16 * dt) = w; }
            }
            ATT_BAR();
            SCHED_FENCE();
            if (newrow) ATT_V_PIECE(h, rs + 8, wave);
            SCHED_FENCE();
        }
        asm volatile("s_waitcnt vmcnt(0) lgkmcnt(0)" ::: "memory");
        __builtin_amdgcn_s_barrier();
    }
#undef ATT_K_PIECE
#undef ATT_V_PIECE
#undef ATT_BAR
}

__device__ __forceinline__ void gmlp_unit(const bf16_t* VTg, const float* lns, const float* ln_g, const float* ln_b, const bf16_t* wsb  , const float* b_s  ,
                                          const bf16_t* U, bf16_t* Y, int unit, int lane) {
    const int cq = unit & 3, g = (unit >> 2) & 7, n = unit >> 5;
    const int fr = lane & 15, fq = lane >> 4;
    const int tok0 = n * 128;
    f32x4 sa[4], sb[4]; u32x4 raw[2][4]; float lg[2], lb[2];
#pragma unroll
    for (int ks = 0; ks < 4; ++ks) { const float* sp = lns + ((size_t)(tok0 + 32 * ks + 8 * fq + (fr & 7)) * 8 + 4 * (fr >> 3)) * 2; sa[ks] = *(const f32x4*)sp; sb[ks] = *(const f32x4*)(sp + 4); }
#pragma unroll
    for (int ct = 0; ct < 2; ++ct) { const int ch = g * 128 + 32 * cq + 16 * ct + fr; lg[ct] = ln_g[ch]; lb[ct] = ln_b[ch];
#pragma unroll
        for (int ks = 0; ks < 4; ++ks) raw[ct][ks] = *(const u32x4*)(VTg + (size_t)ch * T + tok0 + 32 * ks + 8 * fq); }
    const bf16_t* wp0 = wsb + (size_t)(g * 128 + fr) * 128 + 8 * fq;
    const bf16_t* up0 = U + (size_t)(tok0 + fr) * 1024 + g * 128 + 32 * cq + 4 * fq;
    bf16x8 wa[4][4], wb[4][4]; u32x2 ua[4][2], ub[4][2]; float ba[4], bb[4];
#pragma unroll
    for (int pt = 0; pt < 4; ++pt) { ba[pt] = b_s[g * 128 + 16 * pt + fr];
#pragma unroll
        for (int ks = 0; ks < 4; ++ks) wa[pt][ks] = *(const bf16x8*)(wp0 + (size_t)(16 * pt) * 128 + 32 * ks);
#pragma unroll
        for (int ct = 0; ct < 2; ++ct) ua[pt][ct] = *(const u32x2*)(up0 + (size_t)(16 * pt) * 1024 + 16 * ct); }
    SCHED_FENCE();
    bf16x8 af[2][4];
#pragma unroll
    for (int ks = 0; ks < 4; ++ks) {
        float mu[8], rs[8];
        {
            const f32x4 a = sa[ks], b = sb[ks];
            float s = (a[0] + a[2]) + (b[0] + b[2]), q = (a[1] + a[3]) + (b[1] + b[3]);
            s += __shfl_xor(s, 8); q += __shfl_xor(q, 8);
            const float mt = s * (1.0f / 1024.0f), rt = __builtin_amdgcn_rsqf(fmaxf(q * (1.0f / 1024.0f) - mt * mt, 0.f) + LN_EPS);
            const int lb4 = (fq << 4);
#pragma unroll
            for (int j = 0; j < 8; ++j) { mu[j] = __shfl(mt, lb4 | j); rs[j] = __shfl(rt, lb4 | j); }
        }
#pragma unroll
        for (int ct = 0; ct < 2; ++ct) {
            const u32x4 rw = raw[ct][ks];
            float v[8] = {bf_lo(rw.x), bf_hi(rw.x), bf_lo(rw.y), bf_hi(rw.y), bf_lo(rw.z), bf_hi(rw.z), bf_lo(rw.w), bf_hi(rw.w)};
#pragma unroll
            for (int j = 0; j < 8; ++j) v[j] = (v[j] - mu[j]) * rs[j] * lg[ct] + lb[ct];
            u32x4 w; w.x = cvt_pk_bf16(v[0], v[1]); w.y = cvt_pk_bf16(v[2], v[3]); w.z = cvt_pk_bf16(v[4], v[5]); w.w = cvt_pk_bf16(v[6], v[7]);
            af[ct][ks] = __builtin_bit_cast(bf16x8, w);
        }
    }
    SCHED_FENCE();
#pragma unroll
    for (int pt = 0; pt < 4; ++pt) { bb[pt] = b_s[g * 128 + 64 + 16 * pt + fr];
#pragma unroll
        for (int ks = 0; ks < 4; ++ks) wb[pt][ks] = *(const bf16x8*)(wp0 + (size_t)(64 + 16 * pt) * 128 + 32 * ks);
#pragma unroll
        for (int ct = 0; ct < 2; ++ct) ub[pt][ct] = *(const u32x2*)(up0 + (size_t)(64 + 16 * pt) * 1024 + 16 * ct); }
    SCHED_FENCE();
#define GM_HALF(WF, UF, BF, P0) do { _Pragma("unroll") for (int pt = 0; pt < 4; ++pt) { \
        f32x4 a0 = {0.f, 0.f, 0.f, 0.f}, a1 = a0; \
        _Pragma("unroll") for (int ks = 0; ks < 4; ++ks) { a0 = MFMA16(af[0][ks], WF[pt][ks], a0); a1 = MFMA16(af[1][ks], WF[pt][ks], a1); } \
        const float bs = BF[pt]; bf16_t* yp = Y + (size_t)(tok0 + (P0) + 16 * pt + fr) * 2048 + g * 128 + 32 * cq + 4 * fq; \
        _Pragma("unroll") for (int ct = 0; ct < 2; ++ct) { const f32x4 a = ct ? a1 : a0; const u32x2 uw = UF[pt][ct]; \
            u32x2 w; w.x = cvt_pk_bf16(bf_lo(uw.x) * (a[0] + bs), bf_hi(uw.x) * (a[1] + bs)); w.y = cvt_pk_bf16(bf_lo(uw.y) * (a[2] + bs), bf_hi(uw.y) * (a[3] + bs)); \
            *(u32x2*)(yp + 16 * ct) = w; } } } while (0)
    GM_HALF(wa, ua, ba, 0);
    GM_HALF(wb, ub, bb, 64);
#undef GM_HALF
}

__device__ __forceinline__ f32x4 raw4(const bf16_t* p) { const u32x2 w = *(const u32x2*)p; return (f32x4){bf_lo(w.x), bf_hi(w.x), bf_lo(w.y), bf_hi(w.y)}; }
__device__ __forceinline__ void conv_fixup(const bf16_t* RAW, const float* ck, const float* cb, bf16_t* ACT, int gtid, int nthr) {
    constexpr int NJ = FF / 4, NTASK = 128 * 2 * NJ;
    for (int task = gtid; task < NTASK; task += nthr) {
        const int j4 = (task % NJ) * 4, rr = task / NJ, grp = rr >> 1, last = rr & 1;
        const int row = grp * 64 + (last ? 63 : 0);
        const f32x4 z = {0.f, 0.f, 0.f, 0.f};
        f32x4 cv[2];
#pragma unroll
        for (int bj = 0; bj < 2; ++bj) {
            const bf16_t* base = RAW + bj * FF + j4;
            f32x4 pv, cur, nv;
            if (!last) { pv = grp > 0 ? raw4(base + (size_t)((grp - 1) * 4 + 3) * NUP) : z; cur = raw4(base + (size_t)(grp * 4 + 0) * NUP); nv = raw4(base + (size_t)(grp * 4 + 1) * NUP); }
            else { pv = raw4(base + (size_t)(grp * 4 + 2) * NUP); cur = raw4(base + (size_t)(grp * 4 + 3) * NUP); nv = grp < 127 ? raw4(base + (size_t)((grp + 1) * 4 + 0) * NUP) : z; }
            cv[bj] = *(const f32x4*)(ck + 0 * NUP + bj * FF + j4) * pv + *(const f32x4*)(ck + 1 * NUP + bj * FF + j4) * cur + *(const f32x4*)(ck + 2 * NUP + bj * FF + j4) * nv + *(const f32x4*)(cb + bj * FF + j4);
        }
        const f32x4 gt = cv[0], vl = cv[1];
        u32x2 w; w.x = cvt_pk_bf16(gt[0] * sigmoid_f(gt[0]) * vl[0], gt[1] * sigmoid_f(gt[1]) * vl[1]); w.y = cvt_pk_bf16(gt[2] * sigmoid_f(gt[2]) * vl[2], gt[3] * sigmoid_f(gt[3]) * vl[3]);
        *(u32x2*)(ACT + (size_t)row * FF + j4) = w;
    }
}

__global__ void __launch_bounds__(NWAVES * 64, 2) mega_fwd(Params p) {
    extern __shared__ __attribute__((aligned(16))) unsigned char lds_raw[];
    cg::grid_group grid = cg::this_grid();
    LAS unsigned char* lds = (LAS unsigned char*)lds_raw;
    const int G = gridDim.x, bx = blockIdx.x;
    const int NGW = G * NWAVES;
    volatile LAS unsigned* xst = (volatile LAS unsigned*)(lds + LDS_BYTES - 64);
    if (threadIdx.x == 0) { xst[0] = 0u; xst[1] = 0u; }
    __syncthreads();
    XcdBarrier xbar = xcd_barrier_post((unsigned*)p.ws, xst);
#define PHASE_IDS int tid = threadIdx.x; asm volatile("" : "+v"(tid)); const int lane = tid & 63, wave = __builtin_amdgcn_readfirstlane(tid >> 6), gw = bx * NWAVES + wave; (void)lane; (void)gw; (void)wave;
#define PHASE_WS unsigned long long wsv_ = (unsigned long long)p.ws; asm volatile("" : "+s"(wsv_)); __attribute__((address_space(1))) unsigned char* ws = (__attribute__((address_space(1))) unsigned char*)wsv_;
#define WSP(type, off) ((type*)(ws + (off)))

    if (gridDim.x > 4096u) GSYNC_CG();
    { PHASE_IDS p0_prologue(p, lds, gw, NGW, wave, lane); }
    GSYNC();

    for (int l = 0; l < DEPTH; ++l) {
        {
            PHASE_WS
            const __attribute__((address_space(1))) unsigned char* wl = ws + OFF_W + (size_t)l * WL_SIZE;
            pg8::Sched<1> S{(const char*)WSP(bf16_t, OFF_XB0), (const char*)(wl + WL_IN), (size_t)256 * D * 2, (size_t)256 * D * 2, NIN / 256, G, bx};
            pg8::EpiIn E{WSP(float, OFF_SSQP) + (size_t)(2 * l) * T * 32, WSP(bf16_t, OFF_U), WSP(bf16_t, OFF_Q), WSP(bf16_t, OFF_K), WSP(bf16_t, OFF_G), WSP(bf16_t, OFF_VTG), WSP(bf16_t, OFF_VTA), WSP(float, OFF_LNSP) + (size_t)l * T * 16};
            pg8::gemm_phase<pg8::EpiIn, pg8::Sched<1>, true, true>(lds, D, D / 64, S, E);
            {
                PHASE_IDS int idx, cnt; idle_workers(32 * (NIN / 256), G, bx, idx, cnt);
                if (idx >= 0) convert_range(p, lds, l == 0 ? CV_P0 : CV_B, l == 0 ? CV_A : CV_C, idx * NWAVES + wave, cnt * NWAVES, wave, lane);
            }
        }
        GSYNC();
        {
            PHASE_IDS PHASE_WS
            const float* rpb = p.in[7] + (size_t)l * 16 * 465;
            const bf16_t* wsb = WSP(bf16_t, OFF_WSB) + (size_t)l * 8 * 128 * 128;
            if ((bx >> 3) & 1) {
                for (int u = gw; u < 2048; u += NGW) gmlp_unit(WSP(bf16_t, OFF_VTG), WSP(float, OFF_LNSP) + (size_t)l * T * 16, p.in[3] + l * 1024, p.in[4] + l * 1024, wsb, p.in[6] + l * 1024, WSP(bf16_t, OFF_U), WSP(bf16_t, OFF_Y), u, lane);
                __syncthreads();
            }
            attn_phase(WSP(bf16_t, OFF_Q), WSP(bf16_t, OFF_K), WSP(bf16_t, OFF_VTA), rpb, WSP(bf16_t, OFF_Y), lds, bx, G, tid, wave, lane);
            if (!((bx >> 3) & 1)) {
                for (int u = gw; u < 2048; u += NGW) gmlp_unit(WSP(bf16_t, OFF_VTG), WSP(float, OFF_LNSP) + (size_t)l * T * 16, p.in[3] + l * 1024, p.in[4] + l * 1024, wsb, p.in[6] + l * 1024, WSP(bf16_t, OFF_U), WSP(bf16_t, OFF_Y), u, lane);
            }
        }
        GSYNC();
        {
            PHASE_WS
            const __attribute__((address_space(1))) unsigned char* wl = ws + OFF_W + (size_t)l * WL_SIZE;
            pg8::Sched<2> S{(const char*)WSP(bf16_t, OFF_Y), (const char*)(wl + WL_BR), (size_t)256 * D * 2, (size_t)256 * D * 2, D / 256, G, bx};
            pg8::EpiBr E{WSP(bf16_t, OFF_G), WSP(bf16_t, OFF_MG)};
            pg8::gemm_phase<pg8::EpiBr, pg8::Sched<2>, true, true>(lds, D, 1024 / 64, S, E);
        }
        GSYNC();
        {
            PHASE_WS
            const __attribute__((address_space(1))) unsigned char* wl = ws + OFF_W + (size_t)l * WL_SIZE;
            pg8::Sched<0> S{(const char*)WSP(bf16_t, OFF_MG), (const char*)(wl + WL_OUT), (size_t)256 * D * 2, (size_t)256 * D * 2, D / 256, G, bx};
            pg8::EpiRes E{WSP(bf16_t, OFF_XB0), WSP(bf16_t, OFF_XB1), WSP(float, OFF_SSQP) + (size_t)(2 * l + 1) * T * 32};
            pg8::gemm_phase<pg8::EpiRes, pg8::Sched<0>, true, true>(lds, D, D / 64, S, E);
        }
        GSYNC();
        {
            PHASE_WS
            const __attribute__((address_space(1))) unsigned char* wl = ws + OFF_W + (size_t)l * WL_SIZE;
            pg8::Sched<0> S{(const char*)WSP(bf16_t, OFF_XB1), (const char*)(wl + WL_UP), (size_t)256 * D * 2, (size_t)256 * D * 2, NUP / 256, G, bx};
            pg8::EpiUpConv E{WSP(float, OFF_SSQP) + (size_t)(2 * l + 1) * T * 32, p.in[12] + (size_t)l * 3 * NUP, p.in[13] + (size_t)l * NUP, WSP(bf16_t, OFF_ACT), WSP(bf16_t, OFF_RAW)};
            pg8::gemm_phase<pg8::EpiUpConv, pg8::Sched<0>, true, true>(lds, D, D / 64, S, E);
            {
                PHASE_IDS int idx, cnt; idle_workers(32 * (NUP / 256), G, bx, idx, cnt);
                if (idx >= 0) convert_range(p, lds, l == 0 ? CV_A : CV_C, l == 0 ? CV_B : 2 * I_L, idx * NWAVES + wave, cnt * NWAVES, wave, lane);
            }
        }
        GSYNC();
        {
            PHASE_IDS PHASE_WS
            conv_fixup(WSP(bf16_t, OFF_RAW), p.in[12] + (size_t)l * 3 * NUP, p.in[13] + (size_t)l * NUP, WSP(bf16_t, OFF_ACT), bx * (NWAVES * 64) + tid, G * NWAVES * 64);
        }
        GSYNC();
        {
            PHASE_WS
            const __attribute__((address_space(1))) unsigned char* wl = ws + OFF_W + (size_t)l * WL_SIZE;
            pg8::Sched<0> S{(const char*)WSP(bf16_t, OFF_ACT), (const char*)(wl + WL_DN), (size_t)256 * FF * 2, (size_t)256 * FF * 2, D / 256, G, bx};
            pg8::EpiRes E{WSP(bf16_t, OFF_XB1), WSP(bf16_t, OFF_XB0), WSP(float, OFF_SSQP) + (size_t)(2 * l + 2) * T * 32};
            pg8::gemm_phase<pg8::EpiRes, pg8::Sched<0>, true, true>(lds, FF, FF / 64, S, E);
        }
        GSYNC();
    }
    {
        PHASE_IDS PHASE_WS
        const float* gfin = p.in[15]; const float* ssf = WSP(float, OFF_SSQP) + (size_t)4 * T * 32;
        f32x4 gv[8];
#pragma unroll
        for (int j = 0; j < 8; ++j) gv[j] = ((const f32x4*)gfin + lane)[64 * j];
        for (int m = gw; m < T; m += 2 * NGW) {
            const int m2 = m + NGW; const bool two = m2 < T; const int mb = two ? m2 : m;
            const float pa = lane < 32 ? ssf[(size_t)m * 32 + lane] : 0.f, pc = lane < 32 ? ssf[(size_t)mb * 32 + lane] : 0.f;
            const u32x2* xa = (const u32x2*)(WSP(bf16_t, OFF_XB0) + (size_t)m * D) + lane; const u32x2* xc = (const u32x2*)(WSP(bf16_t, OFF_XB0) + (size_t)mb * D) + lane;
            u32x2 wa[8], wc[8];
#pragma unroll
            for (int j = 0; j < 8; ++j) { wa[j] = xa[64 * j]; wc[j] = xc[64 * j]; }
            const float ra = __builtin_amdgcn_rsqf(wave_sum(pa) * (1.0f / D) + RMS_EPS), rc = __builtin_amdgcn_rsqf(wave_sum(pc) * (1.0f / D) + RMS_EPS);
            f32x4* oa = (f32x4*)(p.out + (size_t)m * D) + lane; f32x4* oc = (f32x4*)(p.out + (size_t)m2 * D) + lane;
#pragma unroll
            for (int j = 0; j < 8; ++j) { const u32x2 w = wa[j]; const f32x4 v = {bf_lo(w.x), bf_hi(w.x), bf_lo(w.y), bf_hi(w.y)}; oa[64 * j] = v * ra * gv[j]; }
            if (two) {
#pragma unroll
                for (int j = 0; j < 8; ++j) { const u32x2 w = wc[j]; const f32x4 v = {bf_lo(w.x), bf_hi(w.x), bf_lo(w.y), bf_hi(w.y)}; oc[64 * j] = v * rc * gv[j]; }
            }
        }
    }
}

extern "C" void kernel_launch(void* const* d_in, const int* in_sizes, int n_in, void* d_out, int out_size, void* d_ws, size_t ws_size, hipStream_t stream) {
    static int grid_blocks = 0;
    if (grid_blocks == 0) {
        if (n_in != 16 || out_size != T * D || ws_size < WS_END) { fprintf(stderr, "kernel_launch: unexpected shapes (n_in %d out %d ws %zu)\n", n_in, out_size, ws_size); grid_blocks = -1; return; }
        int dev = 0, cus = 0, per_cu = 0;
        hipGetDevice(&dev);
        hipDeviceGetAttribute(&cus, hipDeviceAttributeMultiprocessorCount, dev);
        hipFuncSetAttribute((const void*)mega_fwd, hipFuncAttributeMaxDynamicSharedMemorySize, LDS_BYTES);
        hipOccupancyMaxActiveBlocksPerMultiprocessor(&per_cu, (const void*)mega_fwd, NWAVES * 64, LDS_BYTES);
        if (per_cu < 1) { fprintf(stderr, "kernel_launch: occupancy query says %d blocks per CU\n", per_cu); per_cu = 1; }
        (void)hipGetLastError();
        grid_blocks = cus * per_cu;
    }
    if (grid_blocks < 0) return;
    Params p{};
    for (int i = 0; i < 16; ++i) p.in[i] = (const float*)d_in[i];
    p.out = (float*)d_out; p.ws = (unsigned char*)d_ws;
    if (hipMemsetAsync(d_ws, 0, 16384, stream) != hipSuccess) { fprintf(stderr, "kernel_launch: memset of the barrier words failed\n"); return; }
    void* args[] = {&p};
    hipError_t e = hipLaunchCooperativeKernel((const void*)mega_fwd, dim3(grid_blocks), dim3(NWAVES * 64), args, LDS_BYTES, stream);
    if (e != hipSuccess) fprintf(stderr, "cooperative launch failed: %s (grid %d)\n", hipGetErrorString(e), grid_blocks);
}
```

```cpp
#include <hip/hip_runtime.h>
#include <hip/hip_cooperative_groups.h>
#include <cstdio>
#include <cstdint>
namespace cg = cooperative_groups;

#define LAS __attribute__((address_space(3)))
typedef unsigned short bf16_t;
typedef short bf16x8 __attribute__((ext_vector_type(8)));
typedef float f32x4 __attribute__((ext_vector_type(4)));
typedef float f32x2 __attribute__((ext_vector_type(2)));
typedef unsigned u32x4 __attribute__((ext_vector_type(4)));
typedef unsigned u32x2 __attribute__((ext_vector_type(2)));

constexpr int T = 8192, D = 2048, NIN = 9216, FF = 5504, NUP = 11008, DEPTH = 2;
constexpr float RMS_EPS = 1e-6f, LN_EPS = 1e-5f;
constexpr int NWAVES = 8;
constexpr int LDS_BYTES = 147456;
#define GSYNC() xcd_barrier(xbar)
#define GSYNC_CG() do { asm volatile("s_waitcnt vmcnt(0) lgkmcnt(0)" ::: "memory"); grid.sync(); __builtin_amdgcn_fence(__ATOMIC_ACQUIRE, "agent"); asm volatile("s_waitcnt vmcnt(0)" ::: "memory"); } while (0)

constexpr size_t MiB = 1u << 20;
constexpr size_t OFF_SSQ = 0;
constexpr size_t OFF_LNS = 256 * 1024;
constexpr size_t OFF_WSB = 1 * MiB;
constexpr size_t OFF_W = 2 * MiB;
constexpr size_t WL_IN = 0, WL_BR = 36 * MiB, WL_OUT = 44 * MiB, WL_UP = 52 * MiB, WL_DN = 95 * MiB, WL_SIZE = 117 * MiB;
constexpr size_t OFF_XB0 = 236 * MiB, OFF_XB1 = 268 * MiB, OFF_X1 = 300 * MiB, OFF_BIG = 364 * MiB;
constexpr size_t OFF_U = OFF_BIG, OFF_Q = OFF_BIG + 16 * MiB, OFF_K = OFF_BIG + 32 * MiB, OFF_VTG = OFF_BIG + 48 * MiB, OFF_VTA = OFF_BIG + 64 * MiB, OFF_G = OFF_BIG + 80 * MiB;
constexpr size_t OFF_Y = OFF_BIG + 144 * MiB, OFF_TMP = OFF_BIG + 176 * MiB, OFF_MG = OFF_BIG + 240 * MiB;
constexpr size_t OFF_UP = OFF_BIG, OFF_ACT = OFF_BIG + 172 * MiB;
constexpr size_t OFF_SSQP = OFF_BIG + 272 * MiB;
constexpr size_t OFF_LNSP = OFF_SSQP + 5 * MiB;
constexpr size_t OFF_RAW = OFF_LNSP + 1 * MiB;
constexpr size_t WS_END = OFF_RAW + 22 * MiB;

__device__ __forceinline__ unsigned cvt_pk_bf16(float lo, float hi) { unsigned r; asm volatile("v_cvt_pk_bf16_f32 %0, %1, %2" : "=v"(r) : "v"(lo), "v"(hi)); return r; }
__device__ __forceinline__ float bf_lo(unsigned w) { return __uint_as_float(w << 16); }
__device__ __forceinline__ float bf_hi(unsigned w) { return __uint_as_float(w & 0xffff0000u); }
__device__ __forceinline__ float fast_rcp(float x) { return __builtin_amdgcn_rcpf(x); }
__device__ __forceinline__ float fast_exp2(float x) { return __builtin_amdgcn_exp2f(x); }
__device__ __forceinline__ float sigmoid_f(float x) { return fast_rcp(1.0f + fast_exp2(-1.4426950409f * x)); }
__device__ __forceinline__ float gelu_tanh(float x) { const float t = x + 0.044715f * x * x * x; return x * fast_rcp(1.0f + fast_exp2(-2.3022081981f * t)); }
__device__ __forceinline__ f32x4 gelu4(f32x4 v) { return (f32x4){gelu_tanh(v[0]), gelu_tanh(v[1]), gelu_tanh(v[2]), gelu_tanh(v[3])}; }
__device__ __forceinline__ f32x4 sigm4(f32x4 v) { return (f32x4){sigmoid_f(v[0]), sigmoid_f(v[1]), sigmoid_f(v[2]), sigmoid_f(v[3])}; }
__device__ __forceinline__ unsigned gate_q4(f32x4 g) {
    const unsigned a = (unsigned)(g[0] * 255.0f + 0.5f), b = (unsigned)(g[1] * 255.0f + 0.5f), c = (unsigned)(g[2] * 255.0f + 0.5f), d = (unsigned)(g[3] * 255.0f + 0.5f);
    return a | (b << 8) | (c << 16) | (d << 24);
}
__device__ __forceinline__ f32x4 gate_d4(unsigned w) {
    return (f32x4){fmaxf((float)(w & 0xffu), 0.5f), fmaxf((float)((w >> 8) & 0xffu), 0.5f), fmaxf((float)((w >> 16) & 0xffu), 0.5f), fmaxf((float)(w >> 24), 0.5f)};
}
__device__ __forceinline__ u32x4 pack8(f32x4 a, f32x4 b) { u32x4 w; w.x = cvt_pk_bf16(a[0], a[1]); w.y = cvt_pk_bf16(a[2], a[3]); w.z = cvt_pk_bf16(b[0], b[1]); w.w = cvt_pk_bf16(b[2], b[3]); return w; }

__device__ __forceinline__ float row_rstd(const float* ssp, int row, int fq) {
    const f32x4 a = *(const f32x4*)(ssp + (size_t)row * 32 + 8 * fq), b = *(const f32x4*)(ssp + (size_t)row * 32 + 8 * fq + 4);
    float s = ((a[0] + a[1]) + (a[2] + a[3])) + ((b[0] + b[1]) + (b[2] + b[3]));
    s += __shfl_xor(s, 16); s += __shfl_xor(s, 32);
    return __builtin_amdgcn_rsqf(s * (1.0f / 2048.0f) + 1e-6f);
}

namespace pg8 {
constexpr int BM = 256, BK = 64, HALF = 128, HTB = HALF * BK * 2, STAGE_BYTES = 8 * HTB, NXCD = 8, WGM = 8;
__host__ __device__ __forceinline__ int lds_byte(int r, int c) { const int st = (r >> 4) * 2 + (c >> 5), rr = r & 15, cc = c & 31, ob = rr * 64 + cc * 2; return st * 1024 + (ob ^ (((ob >> 9) & 1) << 5)); }
__host__ __device__ __forceinline__ void stage_rc(int b, int& R, int& C) { const int st = b / 1024, sb = b % 1024, swz = sb ^ (((sb >> 9) & 1) << 5); R = (st >> 1) * 16 + swz / 64; C = (st & 1) * 32 + (swz % 64) / 2; }
__host__ __device__ __forceinline__ int perm32(int rho) { const int n = rho >> 4, i = rho & 15; return 8 * (i >> 2) + 4 * n + (i & 3); }

struct Unit { int pm, pn, kind; };

__device__ __forceinline__ bool tile_of(long L, int nM, int nN, int& pm, int& pn) {
    const int nwg = nM * nN; if (L >= nwg) return false;
    int wgid = (int)L; { const int q = nwg / NXCD, r = nwg % NXCD, xcd = wgid % NXCD, off = wgid / NXCD; wgid = (xcd < r ? xcd * (q + 1) : r * (q + 1) + (xcd - r) * q) + off; }
    const int nig = WGM * nN, gid = wgid / nig, fm = gid * WGM, gsz = (nM - fm) < WGM ? (nM - fm) : WGM;
    pm = fm + ((wgid % nig) % gsz); pn = (wgid % nig) / gsz; return true;
}

template <int MODE> struct Sched {
    static constexpr int kMode = MODE;
    const char* A; const char* B; size_t tsA, tsB; int nN, G, c;
    __device__ __forceinline__ bool next(int i, Unit& u) const {
        long L; if (MODE == 2) L = (long)(i >> 1) * G + c; else L = (long)i * G + c;
        if (!tile_of(L, 32, nN, u.pm, u.pn)) return false;
        if (MODE == 1) {
            const unsigned long long w = u.pn < 10 ? 0x01442ca2480c2040ull : (u.pn < 20 ? 0x06585d655434c1c6ull : (u.pn < 30 ? 0x07de75c4503ce6daull : 0x00000008e28604d2ull));
            u.pn = (int)((w >> (6 * (u.pn % 10))) & 63ull);
        }
        if (MODE == 1) u.kind = (u.pn >= 4 && u.pn < 8) ? 1 : ((u.pn >= 16 && u.pn < 20) ? 2 : 0);
        else if (MODE == 2) u.kind = i & 1; else u.kind = 0;
        return true;
    }
    __device__ __forceinline__ void ptrs(const Unit& u, const char*& a, const char*& b) const {
        if (MODE == 1 && u.kind != 0) { a = B + (size_t)u.pn * tsB; b = A + (size_t)u.pm * tsA; }
        else { const size_t ko = (MODE == 2) ? (size_t)u.kind * 2048 : 0; a = A + (size_t)u.pm * tsA + ko; b = B + (size_t)u.pn * tsB + ko; }
    }
};

template <class Epi, class SchedT, bool ALIGN_EPI, bool SP2>
__device__ __forceinline__ void gemm_phase(LAS unsigned char* lds, const int ldk, const int nt, const SchedT& S, const Epi& E) {
    int tid = threadIdx.x; asm volatile("" : "+v"(tid));
    const int wid = __builtin_amdgcn_readfirstlane(tid >> 6), lane = tid & 63, wr = wid >> 2, wc = wid & 3, fr = lane & 15, fq = lane >> 4;
    const int K = ldk;
    unsigned voffA[2], voffB[2];
#pragma unroll
    for (int i = 0; i < 2; ++i) { int R, C; stage_rc(tid * 16 + i * 8192, R, C); const int Rb = 2 * (R & ~31) + perm32(R & 31);
        voffA[i] = (unsigned)(R * K + C) * 2u; voffB[i] = (unsigned)(Rb * K + C) * 2u; }
    const size_t kstep = (size_t)(BK * 2);
    const size_t hstep = (size_t)HALF * K * 2;
    const size_t hstepB = (size_t)32 * K * 2;
    const unsigned ldsw = (unsigned)wid * 1024u;
    const int aoff = lds_byte(wr * 64 + fr, fq * 8), boff = lds_byte(wc * 32 + fr, fq * 8);
#define PG8_SA(b, h) (((b) * 2 + (h)) * HTB)
#define PG8_SB(b, h) ((4 + (b) * 2 + (h)) * HTB)
#define PG8_STAGE(bufoff, gbase, voff) do { _Pragma("unroll") for (int _i = 0; _i < 2; ++_i) \
        __builtin_amdgcn_global_load_lds((const __attribute__((address_space(1))) unsigned*)((const char*)(gbase) + (voff)[_i]), (LAS unsigned*)(lds + (bufoff) + ldsw + _i * 8192), 16, 0, 0); } while (0)
#define PG8_LDA(dst, b, h) do { _Pragma("unroll") for (int m = 0; m < 4; ++m) _Pragma("unroll") for (int k = 0; k < 2; ++k) dst[m][k] = *(const LAS bf16x8*)(lds + PG8_SA(b, h) + aoff + m * 2048 + k * 1024); } while (0)
#define PG8_LDB(dst, b, h) do { _Pragma("unroll") for (int n = 0; n < 2; ++n) _Pragma("unroll") for (int k = 0; k < 2; ++k) dst[n][k] = *(const LAS bf16x8*)(lds + PG8_SB(b, h) + boff + n * 2048 + k * 1024); } while (0)
#define PG8_MMA(ai, bj, At, Bt) do { __builtin_amdgcn_s_setprio(1); _Pragma("unroll") for (int m = 0; m < 4; ++m) _Pragma("unroll") for (int n = 0; n < 2; ++n) _Pragma("unroll") for (int k = 0; k < 2; ++k) \
        acc[ai][bj][m][n] = __builtin_amdgcn_mfma_f32_16x16x32_bf16(Bt[n][k], At[m][k], acc[ai][bj][m][n], 0, 0, 0); __builtin_amdgcn_s_setprio(0); } while (0)
#define PG8_WAIT_V(n) asm volatile("s_waitcnt vmcnt(" #n ")" ::: "memory")
#define PG8_WAIT_L(n) asm volatile("s_waitcnt lgkmcnt(" #n ")" ::: "memory")
#define PG8_BAR __builtin_amdgcn_s_barrier()
#define PG8_SCHED __builtin_amdgcn_sched_barrier(0)
    Unit cur, nxt; int ui = 0;
    if (!S.next(0, cur)) return;
    f32x4 acc[2][2][4][2];
#pragma unroll
    for (int a = 0; a < 2; ++a)
#pragma unroll
        for (int b = 0; b < 2; ++b)
#pragma unroll
            for (int m = 0; m < 4; ++m)
#pragma unroll
                for (int n = 0; n < 2; ++n) acc[a][b][m][n] = (f32x4){0.f, 0.f, 0.f, 0.f};
    bf16x8 At[4][2], B0[2][2], B1[2][2];
    const char* cA; const char* cB; S.ptrs(cur, cA, cB);
    if constexpr (SP2) {
        PG8_STAGE(PG8_SB(0, 0), cB, voffB); PG8_STAGE(PG8_SB(0, 1), cB + hstepB, voffB); PG8_STAGE(PG8_SA(0, 0), cA, voffA); PG8_STAGE(PG8_SA(0, 1), cA + hstep, voffA);
        if (wr == 1) PG8_BAR;
        PG8_WAIT_V(2); PG8_BAR;
        PG8_STAGE(PG8_SB(1, 0), cB + kstep, voffB); PG8_STAGE(PG8_SA(1, 0), cA + kstep, voffA); PG8_STAGE(PG8_SB(1, 1), cB + hstepB + kstep, voffB);
        PG8_WAIT_V(6); PG8_BAR;
    } else {
        PG8_STAGE(PG8_SB(0, 0), cB, voffB); PG8_STAGE(PG8_SA(0, 0), cA, voffA); PG8_STAGE(PG8_SB(0, 1), cB + hstepB, voffB); PG8_STAGE(PG8_SA(0, 1), cA + hstep, voffA);
        if (wr == 1) PG8_BAR;
        PG8_WAIT_V(4); PG8_BAR;
        PG8_STAGE(PG8_SB(1, 0), cB + kstep, voffB); PG8_STAGE(PG8_SA(1, 0), cA + kstep, voffA); PG8_STAGE(PG8_SB(1, 1), cB + hstepB + kstep, voffB);
        PG8_WAIT_V(6); PG8_BAR;
    }
    for (;;) {
        const bool has_next = S.next(ui + 1, nxt);
        const char* nA = cA; const char* nB = cB; if (has_next) S.ptrs(nxt, nA, nB);
        for (int t = 0; t < nt; t += 2) {
            const bool last = (t == nt - 2);
            const char* a1 = cA + (size_t)(t + 1) * kstep;
            const char* a2 = last ? nA : cA + (size_t)(t + 2) * kstep; const char* b2 = last ? nB : cB + (size_t)(t + 2) * kstep;
            const char* a3 = a2 + kstep; const char* b3 = b2 + kstep;
            if constexpr (SP2) {
            PG8_LDB(B0, 0, 0); PG8_LDB(B1, 0, 1); PG8_SCHED; PG8_LDA(At, 0, 0); PG8_STAGE(PG8_SA(1, 1), a1 + hstep, voffA);
            PG8_WAIT_V(8); PG8_WAIT_L(0); PG8_BAR; PG8_MMA(0, 0, At, B0); PG8_MMA(0, 1, At, B1); PG8_BAR; PG8_SCHED;
            PG8_LDA(At, 0, 1); PG8_STAGE(PG8_SB(0, 0), b2, voffB); PG8_STAGE(PG8_SB(0, 1), b2 + hstepB, voffB); PG8_STAGE(PG8_SA(0, 0), a2, voffA);
            PG8_WAIT_V(8); PG8_WAIT_L(0); PG8_BAR; PG8_MMA(1, 0, At, B0); PG8_MMA(1, 1, At, B1); PG8_BAR; PG8_SCHED;
            PG8_LDB(B0, 1, 0); PG8_LDB(B1, 1, 1); PG8_SCHED; PG8_LDA(At, 1, 0); PG8_STAGE(PG8_SA(0, 1), a2 + hstep, voffA);
            PG8_WAIT_V(8); PG8_WAIT_L(0); PG8_BAR; PG8_MMA(0, 0, At, B0); PG8_MMA(0, 1, At, B1); PG8_BAR; PG8_SCHED;
            PG8_LDA(At, 1, 1); PG8_STAGE(PG8_SB(1, 0), b3, voffB); PG8_STAGE(PG8_SB(1, 1), b3 + hstepB, voffB); PG8_STAGE(PG8_SA(1, 0), a3, voffA);
            PG8_WAIT_V(8); PG8_WAIT_L(0); PG8_BAR; PG8_MMA(1, 0, At, B0); PG8_MMA(1, 1, At, B1); PG8_BAR; PG8_SCHED;
            } else {
            PG8_LDB(B0, 0, 0); PG8_SCHED; PG8_LDA(At, 0, 0); PG8_STAGE(PG8_SA(1, 1), a1 + hstep, voffA);
            PG8_WAIT_L(8); PG8_BAR; PG8_WAIT_L(0); PG8_MMA(0, 0, At, B0); PG8_BAR; PG8_SCHED;
            PG8_LDB(B1, 0, 1); PG8_STAGE(PG8_SB(0, 0), b2, voffB);
            PG8_BAR; PG8_WAIT_L(0); PG8_MMA(0, 1, At, B1); PG8_BAR;
            PG8_LDA(At, 0, 1); PG8_STAGE(PG8_SA(0, 0), a2, voffA);
            PG8_BAR; PG8_WAIT_L(0); PG8_MMA(1, 0, At, B0); PG8_BAR; PG8_SCHED;
            PG8_STAGE(PG8_SB(0, 1), b2 + hstepB, voffB);
            PG8_WAIT_V(6); PG8_BAR; PG8_MMA(1, 1, At, B1); PG8_BAR;
            PG8_LDB(B0, 1, 0); PG8_SCHED; PG8_LDA(At, 1, 0); PG8_STAGE(PG8_SA(0, 1), a2 + hstep, voffA);
            PG8_WAIT_L(8); PG8_BAR; PG8_WAIT_L(0); PG8_MMA(0, 0, At, B0); PG8_BAR; PG8_SCHED;
            PG8_LDB(B1, 1, 1); PG8_STAGE(PG8_SB(1, 0), b3, voffB);
            PG8_BAR; PG8_WAIT_L(0); PG8_MMA(0, 1, At, B1); PG8_BAR;
            PG8_LDA(At, 1, 1); PG8_STAGE(PG8_SA(1, 0), a3, voffA);
            PG8_BAR; PG8_WAIT_L(0); PG8_MMA(1, 0, At, B0); PG8_BAR; PG8_SCHED;
            PG8_STAGE(PG8_SB(1, 1), b3 + hstepB, voffB);
            PG8_WAIT_V(6); PG8_BAR; PG8_MMA(1, 1, At, B1); PG8_BAR;
            }
        }
        if constexpr (ALIGN_EPI) { if (wr == 0) PG8_BAR; }
        E(acc, cur, wr, wc, fr, fq);
        if (!has_next) break;
        if (!(SchedT::kMode == 2 && cur.kind == 0)) {
#pragma unroll
        for (int a = 0; a < 2; ++a)
#pragma unroll
            for (int b = 0; b < 2; ++b)
#pragma unroll
                for (int m = 0; m < 4; ++m)
#pragma unroll
                    for (int n = 0; n < 2; ++n) acc[a][b][m][n] = (f32x4){0.f, 0.f, 0.f, 0.f};
        }
        cur = nxt; cA = nA; cB = nB; ++ui;
        if constexpr (ALIGN_EPI) { if (wr == 1) PG8_BAR; }
    }
    PG8_WAIT_V(0);
    if constexpr (!ALIGN_EPI) { if (wr == 0) PG8_BAR; }
    PG8_BAR;
#undef PG8_SA
#undef PG8_SB
#undef PG8_STAGE
#undef PG8_LDA
#undef PG8_LDB
#undef PG8_MMA
#undef PG8_WAIT_V
#undef PG8_WAIT_L
#undef PG8_BAR
#undef PG8_SCHED
}

struct EpiIn {
    const float* ss;
    bf16_t *U, *Q, *Kb, *Gt, *VTg, *VTa; float* lns;
    __device__ __forceinline__ void operator()(f32x4 (&acc)[2][2][4][2], const Unit& u, int wr, int wc, int fr, int fq) const {
        if (u.kind == 0) {
            const int pn = u.pn; bf16_t* base; int ldc, colt, mode;
            if (pn < 4) { base = U; ldc = 1024; colt = pn * 256; mode = 0; }
            else if (pn < 12) { base = Q; ldc = 1024; colt = (pn - 8) * 256; mode = 1; }
            else if (pn < 16) { base = Kb; ldc = 1024; colt = (pn - 12) * 256; mode = 2; }
            else { base = U; ldc = 4096; colt = (pn - 20) * 256; mode = 3; }
            const int row0 = u.pm * BM + wr * 64 + fr, col0 = colt + wc * 64 + 8 * fq;
#pragma unroll
            for (int ai = 0; ai < 2; ++ai)
#pragma unroll
                for (int m = 0; m < 4; ++m) {
                    const int row = row0 + ai * HALF + m * 16;
                    float rstd = row_rstd(ss, row, fq); if (mode == 1) rstd *= 0.125f;
                    bf16_t* rowp = base + (size_t)row * ldc + col0;
#pragma unroll
                    for (int bj = 0; bj < 2; ++bj) {
                        f32x4 v0 = acc[ai][bj][m][0] * rstd, v1 = acc[ai][bj][m][1] * rstd;
                        if (mode == 3) { u32x2 w; w.x = gate_q4(sigm4(v0)); w.y = gate_q4(sigm4(v1)); *(u32x2*)((unsigned char*)Gt + (size_t)row * 4096 + col0 + bj * 32) = w; continue; }
                        if (mode == 0) { v0 = gelu4(v0); v1 = gelu4(v1); }
                        *(u32x4*)(rowp + bj * 32) = pack8(v0, v1);
                    }
                }
        } else {
            const bool isg = (u.kind == 1);
            const int ch0 = (isg ? (u.pn - 4) : (u.pn - 16)) * 256 + wr * 64 + fr;
            const int tok0 = u.pm * BM + wc * 64 + 8 * fq;
            bf16_t* base = isg ? VTg : VTa;
#pragma unroll
            for (int bj = 0; bj < 2; ++bj) {
                const int tok = tok0 + bj * 32;
                f32x4 r0, r1;
                {
                    const float* sp = ss + (size_t)(tok + (fr & 7)) * 32 + 16 * (fr >> 3);
                    const f32x4 a = *(const f32x4*)sp, b = *(const f32x4*)(sp + 4), c = *(const f32x4*)(sp + 8), d = *(const f32x4*)(sp + 12);
                    float s = (((a[0] + a[1]) + (a[2] + a[3])) + ((b[0] + b[1]) + (b[2] + b[3]))) + (((c[0] + c[1]) + (c[2] + c[3])) + ((d[0] + d[1]) + (d[2] + d[3])));
                    s += __shfl_xor(s, 8);
                    const float rt = __builtin_amdgcn_rsqf(s * (1.0f / D) + RMS_EPS);
                    const int lb = (fq << 4);
#pragma unroll
                    for (int j = 0; j < 4; ++j) { r0[j] = __shfl(rt, lb | j); r1[j] = __shfl(rt, lb | (4 + j)); }
                }
                f32x4 s0 = {0.f, 0.f, 0.f, 0.f}, s1 = s0, q0 = s0, q1 = s0;
#pragma unroll
                for (int ai = 0; ai < 2; ++ai)
#pragma unroll
                    for (int m = 0; m < 4; ++m) {
                        const int ch = ch0 + ai * HALF + m * 16;
                        f32x4 v0 = acc[ai][bj][m][0] * r0, v1 = acc[ai][bj][m][1] * r1;
                        if (isg) { v0 = gelu4(v0); v1 = gelu4(v1); s0 += v0; s1 += v1; q0 += v0 * v0; q1 += v1 * v1; }
                        *(u32x4*)(base + (size_t)ch * T + tok) = pack8(v0, v1);
                    }
                if (isg) {
#pragma unroll
                    for (int o = 1; o < 16; o <<= 1) {
#pragma unroll
                        for (int j = 0; j < 4; ++j) { s0[j] += __shfl_xor(s0[j], o); s1[j] += __shfl_xor(s1[j], o); q0[j] += __shfl_xor(q0[j], o); q1[j] += __shfl_xor(q1[j], o); }
                    }
#pragma unroll
                    for (int j = 0; j < 4; ++j) {
                        const int pidx = (u.pn - 4) * 2 + wr;
                        if (fr == j)     *(f32x2*)(lns + ((size_t)(tok + j) * 8 + pidx) * 2) = (f32x2){s0[j], q0[j]};
                        if (fr == 4 + j) *(f32x2*)(lns + ((size_t)(tok + 4 + j) * 8 + pidx) * 2) = (f32x2){s1[j], q1[j]};
                    }
                }
            }
        }
    }
};

struct EpiBr {
    const bf16_t* Gt; bf16_t* MG;
    __device__ __forceinline__ void operator()(f32x4 (&acc)[2][2][4][2], const Unit& u, int wr, int wc, int fr, int fq) const {
        const int row0 = u.pm * BM + wr * 64 + fr, col0 = u.pn * BM + wc * 64 + 8 * fq;
#pragma unroll
        for (int ai = 0; ai < 2; ++ai)
#pragma unroll
            for (int m = 0; m < 4; ++m) {
                const int row = row0 + ai * HALF + m * 16;
#pragma unroll
                for (int bj = 0; bj < 2; ++bj) {
                    const int col = col0 + bj * 32;
                    const unsigned char* grow = (const unsigned char*)Gt + (size_t)row * 4096 + col;
                    const u32x2 gw = *(const u32x2*)(grow + 2048);
                    f32x4 g0 = gate_d4(gw.x), g1 = gate_d4(gw.y);
                    if (u.kind == 0) {
                        const u32x2 aw = *(const u32x2*)grow;
                        const f32x4 a0 = gate_d4(aw.x), a1 = gate_d4(aw.y);
#pragma unroll
                        for (int j = 0; j < 4; ++j) { g0[j] = a0[j] * fast_rcp(g0[j]); g1[j] = a1[j] * fast_rcp(g1[j]); }
                        acc[ai][bj][m][0] *= g0; acc[ai][bj][m][1] *= g1;
                    } else {
                        *(u32x4*)(MG + (size_t)row * D + col) = pack8(acc[ai][bj][m][0] * (g0 * (1.0f / 255.0f)), acc[ai][bj][m][1] * (g1 * (1.0f / 255.0f)));
                    }
                }
            }
    }
};

struct EpiRes {
    const bf16_t* xin; bf16_t* xb; float* ss;
    __device__ __forceinline__ void operator()(f32x4 (&acc)[2][2][4][2], const Unit& u, int wr, int wc, int fr, int fq) const {
        const int row0 = u.pm * BM + wr * 64 + fr, col0 = u.pn * BM + wc * 64 + 8 * fq;
#pragma unroll
        for (int ai = 0; ai < 2; ++ai)
#pragma unroll
            for (int m = 0; m < 4; ++m) {
                const int row = row0 + ai * HALF + m * 16; float sq = 0.f;
#pragma unroll
                for (int bj = 0; bj < 2; ++bj) {
                    const size_t off = (size_t)row * D + col0 + bj * 32;
                    const u32x4 xw = *(const u32x4*)(xin + off);
                    const f32x4 v0 = acc[ai][bj][m][0] + (f32x4){bf_lo(xw.x), bf_hi(xw.x), bf_lo(xw.y), bf_hi(xw.y)}, v1 = acc[ai][bj][m][1] + (f32x4){bf_lo(xw.z), bf_hi(xw.z), bf_lo(xw.w), bf_hi(xw.w)};
                    *(u32x4*)(xb + off) = pack8(v0, v1);
                    sq += (v0[0] * v0[0] + v0[1] * v0[1]) + (v0[2] * v0[2] + v0[3] * v0[3]) + (v1[0] * v1[0] + v1[1] * v1[1]) + (v1[2] * v1[2] + v1[3] * v1[3]);
                }
                sq += __shfl_xor(sq, 16); sq += __shfl_xor(sq, 32);
                if (fq == 0) ss[(size_t)row * 32 + u.pn * 4 + wc] = sq;
            }
    }
};

struct EpiUpConv {
    const float* ss; const float* ck; const float* cb; bf16_t* ACT; bf16_t* RAW;
    __device__ __forceinline__ void operator()(f32x4 (&acc)[2][2][4][2], const Unit& u, int wr, int wc, int fr, int fq) const {
        const int row0 = u.pm * BM + wr * 64 + fr;
#pragma unroll
        for (int ai = 0; ai < 2; ++ai)
#pragma unroll
            for (int m = 0; m < 4; ++m) { const float rstd = row_rstd(ss, row0 + ai * HALF + m * 16, fq);
#pragma unroll
                for (int bj = 0; bj < 2; ++bj) { acc[ai][bj][m][0] *= rstd; acc[ai][bj][m][1] *= rstd; } }
#pragma unroll
        for (int n = 0; n < 2; ++n) {
            const int j4 = u.pn * 128 + wc * 32 + 8 * fq + 4 * n;
            f32x4 kc[2][3], bc[2];
#pragma unroll
            for (int bj = 0; bj < 2; ++bj) { bc[bj] = *(const f32x4*)(cb + bj * FF + j4);
#pragma unroll
                for (int w = 0; w < 3; ++w) kc[bj][w] = *(const f32x4*)(ck + w * NUP + bj * FF + j4); }
#pragma unroll
            for (int ai = 0; ai < 2; ++ai) {
                const int grp = u.pm * 4 + ai * 2 + wr;
#pragma unroll
                for (int m = 0; m < 4; ++m) {
                    f32x4 cv[2];
#pragma unroll
                    for (int bj = 0; bj < 2; ++bj) {
                        const f32x4 cur = acc[ai][bj][m][n], lo = acc[ai][bj][m > 0 ? m - 1 : 0][n], hi = acc[ai][bj][m < 3 ? m + 1 : 3][n];
                        f32x4 pv, nv;
#pragma unroll
                        for (int idx = 0; idx < 4; ++idx) {
                            const float y = (fr == 15) ? lo[idx] : cur[idx], z = (fr == 0) ? hi[idx] : cur[idx];
                            pv[idx] = __int_as_float(__builtin_amdgcn_update_dpp(0, __float_as_int(y), 0x121, 0xf, 0xf, false));
                            nv[idx] = __int_as_float(__builtin_amdgcn_update_dpp(0, __float_as_int(z), 0x12f, 0xf, 0xf, false));
                        }
                        cv[bj] = kc[bj][0] * pv + kc[bj][1] * cur + kc[bj][2] * nv + bc[bj];
                    }
                    const int row = row0 + ai * HALF + m * 16;
                    const bool edge = (m == 0 && fr == 0) || (m == 3 && fr == 15);
                    if (!edge) { const f32x4 gt = cv[0], vl = cv[1];
                        u32x2 w; w.x = cvt_pk_bf16(gt[0] * sigmoid_f(gt[0]) * vl[0], gt[1] * sigmoid_f(gt[1]) * vl[1]); w.y = cvt_pk_bf16(gt[2] * sigmoid_f(gt[2]) * vl[2], gt[3] * sigmoid_f(gt[3]) * vl[3]);
                        *(u32x2*)(ACT + (size_t)row * FF + j4) = w; }
                    if (m == 0 && fr < 2) {
#pragma unroll
                        for (int bj = 0; bj < 2; ++bj) { const f32x4 v = acc[ai][bj][0][n]; u32x2 w; w.x = cvt_pk_bf16(v[0], v[1]); w.y = cvt_pk_bf16(v[2], v[3]); *(u32x2*)(RAW + ((size_t)(grp * 4 + fr)) * NUP + bj * FF + j4) = w; } }
                    if (m == 3 && fr >= 14) {
#pragma unroll
                        for (int bj = 0; bj < 2; ++bj) { const f32x4 v = acc[ai][bj][3][n]; u32x2 w; w.x = cvt_pk_bf16(v[0], v[1]); w.y = cvt_pk_bf16(v[2], v[3]); *(u32x2*)(RAW + ((size_t)(grp * 4 + 2 + (fr - 14))) * NUP + bj * FF + j4) = w; } }
                }
            }
        }
    }
};
}

#define XB_TMO      128
#define XB_XCNT(j)  (256  + 64 * (j))
#define XB_XSUB(j)  (1280 + 64 * (j))
#define XB_XGEN(j)  (2304 + 64 * (j))
#define XB_TOP      3328
#define XB_TOPGEN   3392
#define XCD_BAR_WORDS 3456
#define XB_SPIN_CAP (1u << 18)

__device__ __forceinline__ unsigned xb_ld(unsigned* p)              { return __hip_atomic_load(p, __ATOMIC_RELAXED, __HIP_MEMORY_SCOPE_AGENT); }
__device__ __forceinline__ unsigned xb_add(unsigned* p, unsigned v) { return __hip_atomic_fetch_add(p, v, __ATOMIC_RELAXED, __HIP_MEMORY_SCOPE_AGENT); }
__device__ __forceinline__ unsigned xb_xcc_id() { return (unsigned)__builtin_amdgcn_s_getreg((3 << 11) | 20) & 0xFu; }
#define XB_SPIN(cond, bar) do { unsigned _sp = 0; while (cond) { __builtin_amdgcn_s_sleep(1); \
    if ((++_sp & 255u) == 0u) { if (xb_ld(&(bar)[XB_TMO])) break; if (_sp > XB_SPIN_CAP) { atomicAdd(&(bar)[XB_TMO], 1u); break; } } } } while (0)

struct XcdBarrier {
    unsigned* bar; unsigned x;
    volatile LAS unsigned* st;
};

__device__ __forceinline__ XcdBarrier xcd_barrier_post(unsigned* bar, volatile LAS unsigned* st) {
    XcdBarrier b; b.bar = bar; b.x = xb_xcc_id(); b.st = st;
    if (threadIdx.x == 0) (void)xb_add(&bar[XB_XCNT(b.x)], 1u);
    return b;
}
__device__ __forceinline__ void xcd_barrier_complete(unsigned* bar, unsigned x, unsigned& nloc, unsigned& nx) {
    const unsigned G = gridDim.x * gridDim.y * gridDim.z;
    unsigned sum, cnt, mine, sp = 0u;
    for (;;) {
        sum = 0u; cnt = 0u; mine = 0u;
#pragma unroll
        for (unsigned j = 0; j < 16; ++j) { const unsigned c = xb_ld(&bar[XB_XCNT(j)]); sum += c; cnt += (c > 0u) ? 1u : 0u; mine = (j == x) ? c : mine; }
        if (sum == G) break;
        __builtin_amdgcn_s_sleep(1);
        if ((++sp & 255u) == 0u) { if (xb_ld(&bar[XB_TMO])) break; if (sp > XB_SPIN_CAP) { atomicAdd(&bar[XB_TMO], 1u); break; } }
    }
    nloc = mine > 0u ? mine : 1u; nx = cnt > 0u ? cnt : 1u;
}

__device__ __forceinline__ void xcd_barrier(const XcdBarrier& b) {
    asm volatile("s_waitcnt vmcnt(0)" ::: "memory");
    __syncthreads();
    if (threadIdx.x == 0) {
        unsigned* bar = b.bar;
        __builtin_amdgcn_s_waitcnt(0);
        unsigned nloc = b.st[0], nx = b.st[1];
        if (nloc == 0u) { xcd_barrier_complete(bar, b.x, nloc, nx); b.st[0] = nloc; b.st[1] = nx; }
        const unsigned old = xb_add(&bar[XB_XSUB(b.x)], 1u);
        const unsigned gen = old / nloc;
        if (old + 1u == (gen + 1u) * nloc) {
            __builtin_amdgcn_fence(__ATOMIC_RELEASE, "agent");
            asm volatile("s_waitcnt vmcnt(0)" ::: "memory");
            const unsigned og = xb_add(&bar[XB_TOP], 1u);
            const unsigned tg = og / nx;
            if (og + 1u == (tg + 1u) * nx) xb_add(&bar[XB_TOPGEN], 1u);
            else XB_SPIN(xb_ld(&bar[XB_TOPGEN]) == tg, bar);
            __builtin_amdgcn_fence(__ATOMIC_ACQUIRE, "agent");
            xb_add(&bar[XB_XGEN(b.x)], 1u);
            asm volatile("s_waitcnt vmcnt(0)" ::: "memory");
        } else {
            XB_SPIN(xb_ld(&bar[XB_XGEN(b.x)]) == gen, bar);
            __builtin_amdgcn_fence(__ATOMIC_ACQUIRE, "agent");
            asm volatile("s_waitcnt vmcnt(0)" ::: "memory");
        }
    }
    __syncthreads();
}


__device__ __forceinline__ float wave_sum(float v) {
#pragma unroll
    for (int o = 1; o < 64; o <<= 1) v += __shfl_xor(v, o);
    return v;
}
template <bool UPPERM> __device__ __forceinline__ void p0_transpose_item(const float* W, int K, int N, bf16_t* WT, const float* gk, LAS float* scr, int item, int lane) {
    const int nblk = N / 64, kb = item / nblk, nb = item % nblk, k0 = 64 * kb, n0 = 64 * nb;
    const int dn0 = !UPPERM ? n0 : (n0 < FF ? ((n0 >> 7) * 256 + 2 * (n0 & 127)) : ((((n0 - FF) >> 7) * 256) + 2 * ((n0 - FF) & 127) + 32));
    const int r4 = lane >> 4, c4 = (lane & 15) * 4;
    f32x4 v[16];
#pragma unroll
    for (int i = 0; i < 16; ++i) v[i] = *(const f32x4*)(W + (size_t)(k0 + 4 * i + r4) * N + n0 + c4);
    if (gk) {
#pragma unroll
        for (int i = 0; i < 16; ++i) v[i] *= gk[k0 + 4 * i + r4];
    }
#pragma unroll
    for (int i = 0; i < 16; ++i) { LAS float* d = scr + (4 * i + r4) * 65 + c4; d[0] = v[i][0]; d[1] = v[i][1]; d[2] = v[i][2]; d[3] = v[i][3]; }
    asm volatile("s_waitcnt lgkmcnt(0)" ::: "memory");
    const int c = lane & 7;
#pragma unroll
    for (int j = 0; j < 8; ++j) { const int n = (lane >> 3) + 8 * j; const LAS float* s = scr + (8 * c) * 65 + n;
        u32x4 o; o.x = cvt_pk_bf16(s[0 * 65], s[1 * 65]); o.y = cvt_pk_bf16(s[2 * 65], s[3 * 65]); o.z = cvt_pk_bf16(s[4 * 65], s[5 * 65]); o.w = cvt_pk_bf16(s[6 * 65], s[7 * 65]);
        *(u32x4*)(WT + (size_t)(dn0 + (UPPERM ? ((n >> 5) * 64 + (n & 31)) : n)) * K + k0 + 8 * c) = o; }
    asm volatile("s_waitcnt lgkmcnt(0)" ::: "memory");
}

struct Params { const float* in[16]; float* out; unsigned char* ws; };

constexpr int I_IN = (D / 64) * (NIN / 64), I_BR = (D / 64) * (D / 64), I_OUT = I_BR, I_UP = (D / 64) * (NUP / 64), I_DN = (FF / 64) * (D / 64);
constexpr int I_L = I_IN + I_BR + I_OUT + I_UP + I_DN;
constexpr int CV_P0 = 8000, CV_A = 14144, CV_B = I_L + I_IN + I_BR + I_OUT, CV_C = 2 * I_L - I_DN;
static_assert(CV_P0 >= I_IN + I_BR + I_OUT && CV_P0 <= CV_A && CV_A <= I_L + I_IN && CV_A >= I_IN + I_BR + I_OUT && CV_B == I_L + I_IN + I_BR + I_OUT && CV_C == I_L + I_IN + I_BR + I_OUT + I_UP, "conversion plan");
__device__ __forceinline__ void convert_range(const Params& p, LAS unsigned char* lds, int lo, int hi, int widx, int nw, int wave, int lane) {
    LAS float* scr = (LAS float*)(lds + wave * 16640);
    for (int it = lo + widx; it < hi; it += nw) {
        const int l = it / I_L; int r = it % I_L; unsigned char* wl = p.ws + OFF_W + (size_t)l * WL_SIZE;
        const float* W; int K, N; bf16_t* WT; const float* gk = nullptr; bool upp = false;
        if (r < I_IN) { W = p.in[2] + (size_t)l * D * NIN; K = D; N = NIN; WT = (bf16_t*)(wl + WL_IN); gk = p.in[1] + l * D; }
        else if ((r -= I_IN) < I_BR) { W = p.in[8] + (size_t)l * D * D; K = D; N = D; WT = (bf16_t*)(wl + WL_BR); }
        else if ((r -= I_BR) < I_OUT) { W = p.in[9] + (size_t)l * D * D; K = D; N = D; WT = (bf16_t*)(wl + WL_OUT); }
        else if ((r -= I_OUT) < I_UP) { W = p.in[11] + (size_t)l * D * NUP; K = D; N = NUP; WT = (bf16_t*)(wl + WL_UP); gk = p.in[10] + l * D; upp = true; }
        else { r -= I_UP; W = p.in[14] + (size_t)l * FF * D; K = FF; N = D; WT = (bf16_t*)(wl + WL_DN); }
        if (upp) p0_transpose_item<true>(W, K, N, WT, gk, scr, r, lane); else p0_transpose_item<false>(W, K, N, WT, gk, scr, r, lane);
    }
}
__device__ __forceinline__ void idle_workers(int nwg, int G, int c, int& idx, int& cnt) {
    const int rounds = (nwg + G - 1) / G, full = nwg - (rounds - 1) * G;
    if (full >= G) { idx = c; cnt = G; } else { idx = c - full; cnt = G - full; }
}

__device__ __forceinline__ void p0_prologue(const Params& p, LAS unsigned char* lds, int gw, int NGW, int wave, int lane) {
    unsigned char* ws = p.ws;
    { const float* wsrc = p.in[5]; bf16_t* wsb = (bf16_t*)(ws + OFF_WSB); const int gt = gw * 64 + lane, NT = NGW * 64;
      for (int i = gt; i < DEPTH * 8 * 128 * 128 / 2; i += NT) { const f32x2 v = *(const f32x2*)(wsrc + 2 * i); ((unsigned*)wsb)[i] = cvt_pk_bf16(v.x, v.y); } }
    { const float* x = p.in[0]; bf16_t* xb = (bf16_t*)(ws + OFF_XB0); float* ssq = (float*)(ws + OFF_SSQP);
      for (int m = gw; m < T; m += 2 * NGW) {
          const int m2 = m + NGW; const bool two = m2 < T; const int mb = two ? m2 : m;
          const f32x4* xa = (const f32x4*)(x + (size_t)m * D) + lane; const f32x4* xc = (const f32x4*)(x + (size_t)mb * D) + lane;
          f32x4 va[8], vc[8];
#pragma unroll
          for (int j = 0; j < 8; ++j) va[j] = xa[64 * j];
#pragma unroll
          for (int j = 0; j < 8; ++j) vc[j] = xc[64 * j];
          { u32x2* o = (u32x2*)(xb + (size_t)m * D) + lane; float s = 0.f;
#pragma unroll
            for (int j = 0; j < 8; ++j) { const f32x4 v = va[j]; s += (v[0] * v[0] + v[1] * v[1]) + (v[2] * v[2] + v[3] * v[3]); u32x2 w; w.x = cvt_pk_bf16(v[0], v[1]); w.y = cvt_pk_bf16(v[2], v[3]); o[64 * j] = w; }
            s = wave_sum(s); if (lane < 32) ssq[(size_t)m * 32 + lane] = (lane == 0) ? s : 0.f; }
          if (two) { u32x2* o = (u32x2*)(xb + (size_t)m2 * D) + lane; float s = 0.f;
#pragma unroll
            for (int j = 0; j < 8; ++j) { const f32x4 v = vc[j]; s += (v[0] * v[0] + v[1] * v[1]) + (v[2] * v[2] + v[3] * v[3]); u32x2 w; w.x = cvt_pk_bf16(v[0], v[1]); w.y = cvt_pk_bf16(v[2], v[3]); o[64 * j] = w; }
            s = wave_sum(s); if (lane < 32) ssq[(size_t)m2 * 32 + lane] = (lane == 0) ? s : 0.f; } } }
    convert_range(p, lds, 0, CV_P0, gw, NGW, wave, lane);
}

#define MFMA16(a, b, c) __builtin_amdgcn_mfma_f32_16x16x32_bf16((a), (b), (c), 0, 0, 0)

#define SCHED_FENCE() __builtin_amdgcn_sched_barrier(0)
__device__ __forceinline__ int att_fk(int key) { return ((key >> 3) & 3) + 4 * ((key >> 1) & 1); }
__device__ __forceinline__ int att_fv(int dh) { return (dh >> 1) & 7; }
__device__ __forceinline__ void attn_phase(const bf16_t* Q, const bf16_t* Kb, const bf16_t* VTa, const float* rpb, bf16_t* Y, LAS unsigned char* lds, int bx, int G, int tid, int wave, int lane) {
    const int g = wave & 3, hf = wave >> 2;
    const int fr = lane & 15, fq = lane >> 4;
    const int cs = (g == 0) ? 0 : ((g == 1) ? 8 : ((g == 2) ? 24 : 32));
    const int c = 16 * g + fr;
    const int colstart = min(max(c - 8, 0), 48);
    const int kc0 = cs + 8 * fq;
    const int dci0 = kc0 - c + 15;
    const int wlo = max(colstart - kc0, 0), wwd = max(min(colstart + 16 - kc0, 8) - wlo, 0);
    LAS unsigned char* KL = lds; LAS unsigned char* VL = lds + 65536; LAS float* rl = (LAS float*)(lds + 131072);
    const int lr = lane >> 3, lc = lane & 7;
#define ATT_K_PIECE(h_, row_, kg_) do { const int key = (kg_) * 8 + lr; \
        __builtin_amdgcn_global_load_lds((const __attribute__((address_space(1))) unsigned*)(Kb + ((size_t)(row_) * 64 + key) * 1024 + (h_) * 64 + 8 * (lc ^ att_fk(key))), (LAS unsigned*)(KL + ((row_) & 7) * 8192 + (kg_) * 1024), 16, 0, 0); } while (0)
#define ATT_V_PIECE(h_, row_, dg_) do { const int dh = (dg_) * 8 + lr; \
        __builtin_amdgcn_global_load_lds((const __attribute__((address_space(1))) unsigned*)(VTa + (size_t)((h_) * 64 + dh) * T + (size_t)(row_) * 64 + 8 * (lc ^ att_fv(dh))), (LAS unsigned*)(VL + ((row_) & 7) * 8192 + (dg_) * 1024), 16, 0, 0); } while (0)
#define ATT_BAR() do { asm volatile("s_waitcnt lgkmcnt(0)" ::: "memory"); __builtin_amdgcn_s_barrier(); asm volatile("" ::: "memory"); } while (0)
    for (int bu = bx; bu < 256; bu += G) {
        const int h = bu & 15, r0 = (bu >> 4) * 8;
        {
            const int rs0 = min(max(r0 - 4, 0), 120);
#pragma unroll
            for (int pc = 0; pc < 8; ++pc) { ATT_K_PIECE(h, rs0 + wave, pc); ATT_V_PIECE(h, rs0 + wave, pc); }
            rl[tid] = (tid < 465) ? rpb[h * 465 + min(tid, 464)] : -1.0e30f;
        }
        bf16x8 qf0, qf1;
        { const bf16_t* qp = Q + (size_t)(r0 * 64 + c) * 1024 + h * 64 + 8 * fq; qf0 = *(const bf16x8*)qp; qf1 = *(const bf16x8*)(qp + 32); }
        asm volatile("s_waitcnt vmcnt(0)" ::: "memory");
        ATT_BAR();
        for (int n = 0; n < 8; ++n) {
            const int r = r0 + n, rs = min(max(r - 4, 0), 120);
            const bool has_next = n < 7; const int rsn = min(max(r + 1 - 4, 0), 120); const bool newrow = has_next && (rsn != rs);
            asm volatile("s_waitcnt vmcnt(1)" ::: "memory");
            ATT_BAR();
            f32x4 s[4][2];
            float mx = -3.0e38f;
#pragma unroll
            for (int ii = 0; ii < 4; ++ii) {
                const int i = 4 * hf + ii, dr = rs + i - r + 7;
                float bia[8];
#pragma unroll
                for (int j = 0; j < 8; ++j) bia[j] = rl[((unsigned)(j - wlo) < (unsigned)wwd) ? dr * 31 + dci0 + j : 480];
#pragma unroll
                for (int ta = 0; ta < 2; ++ta) {
                    const int key = cs + 8 * (fr >> 2) + 4 * ta + (fr & 3), fk = att_fk(key);
                    const LAS unsigned char* kp = KL + ((rs + i) & 7) * 8192 + key * 128;
                    const bf16x8 kf0 = *(const LAS bf16x8*)(kp + ((fq ^ fk) << 4)), kf1 = *(const LAS bf16x8*)(kp + (((4 + fq) ^ fk) << 4));
                    f32x4 a = {0.f, 0.f, 0.f, 0.f};
                    a = MFMA16(kf0, qf0, a); a = MFMA16(kf1, qf1, a);
#pragma unroll
                    for (int idx = 0; idx < 4; ++idx) { a[idx] += bia[4 * ta + idx]; mx = fmaxf(mx, a[idx]); }
                    s[ii][ta] = a;
                }
            }
            ATT_BAR();
            SCHED_FENCE();
            if (newrow) ATT_K_PIECE(h, rs + 8, wave);
            SCHED_FENCE();
            if (has_next) { const bf16_t* qp = Q + (size_t)((r + 1) * 64 + c) * 1024 + h * 64 + 8 * fq; qf0 = *(const bf16x8*)qp; qf1 = *(const bf16x8*)(qp + 32); }
            SCHED_FENCE();
            mx = fmaxf(mx, __shfl_xor(mx, 16)); mx = fmaxf(mx, __shfl_xor(mx, 32));
            float l = 0.f;
            bf16x8 pb[4];
#pragma unroll
            for (int ii = 0; ii < 4; ++ii) {
                f32x4 p0, p1;
#pragma unroll
                for (int idx = 0; idx < 4; ++idx) { p0[idx] = fast_exp2((s[ii][0][idx] - mx) * 1.4426950409f); p1[idx] = fast_exp2((s[ii][1][idx] - mx) * 1.4426950409f); }
                l += (p0[0] + p0[1]) + (p0[2] + p0[3]) + (p1[0] + p1[1]) + (p1[2] + p1[3]);
                const u32x4 pw = pack8(p0, p1); pb[ii] = __builtin_bit_cast(bf16x8, pw);
            }
            l += __shfl_xor(l, 16); l += __shfl_xor(l, 32);
            SCHED_FENCE();
            if (newrow) asm volatile("s_waitcnt vmcnt(3)" ::: "memory"); else if (has_next) asm volatile("s_waitcnt vmcnt(2)" ::: "memory"); else asm volatile("s_waitcnt vmcnt(0)" ::: "memory");
            ATT_BAR();
            f32x4 o[4];
#pragma unroll
            for (int dt = 0; dt < 4; ++dt) o[dt] = (f32x4){0.f, 0.f, 0.f, 0.f};
#pragma unroll
            for (int ii = 0; ii < 4; ++ii) {
                const int i = 4 * hf + ii;
#pragma unroll
                for (int dt = 0; dt < 4; ++dt) { const int dh = 16 * dt + fr;
                    const bf16x8 vf = *(const LAS bf16x8*)(VL + ((rs + i) & 7) * 8192 + dh * 128 + ((((cs >> 3) + fq) ^ att_fv(dh)) << 4));
                    o[dt] = MFMA16(vf, pb[ii], o[dt]); }
            }
            LAS float* ml = (LAS float*)(lds + 131072 + 2048) + (size_t)(g * 64 + lane) * 2;
            LAS u32x2* ol = (LAS u32x2*)(lds + 131072 + 4096) + (size_t)(g * 64 + lane) * 4;
            if (hf == 1) {
#pragma unroll
                for (int dt = 0; dt < 4; ++dt) { u32x2 w; w.x = cvt_pk_bf16(o[dt][0], o[dt][1]); w.y = cvt_pk_bf16(o[dt][2], o[dt][3]); ol[dt] = w; }
                ml[0] = mx; ml[1] = l;
            }
            ATT_BAR();
            if (hf == 0) {
                const float m1 = ml[0], l1 = ml[1];
                const float m = fmaxf(mx, m1), sc0 = fast_exp2((mx - m) * 1.4426950409f), sc1 = fast_exp2((m1 - m) * 1.4426950409f);
                const float inv = 1.0f / (l * sc0 + l1 * sc1);
                bf16_t* yp = Y + (size_t)(r * 64 + c) * 2048 + 1024 + h * 64 + 4 * fq;
#pragma unroll
                for (int dt = 0; dt < 4; ++dt) { const u32x2 pw = ol[dt]; const f32x4 o1 = {bf_lo(pw.x), bf_hi(pw.x), bf_lo(pw.y), bf_hi(pw.y)}; const f32x4 v = (o[dt] * sc0 + o1 * sc1) * inv;
                    u32x2 w; w.x = cvt_pk_bf16(v[0], v[1]); w.y = cvt_pk_bf16(v[2], v[3]); *(u32x2*)(yp + 16 * dt) = w; }
            }
            ATT_BAR();
            SCHED_FENCE();
            if (newrow) ATT_V_PIECE(h, rs + 8, wave);
            SCHED_FENCE();
        }
        asm volatile("s_waitcnt vmcnt(0) lgkmcnt(0)" ::: "memory");
        __builtin_amdgcn_s_barrier();
    }
#undef ATT_K_PIECE
#undef ATT_V_PIECE
#undef ATT_BAR
}

__device__ __forceinline__ void gmlp_unit(const bf16_t* VTg, const float* lns, const float* ln_g, const float* ln_b, const bf16_t* wsb  , const float* b_s  ,
                                          const bf16_t* U, bf16_t* Y, int unit, int lane) {
    const int cq = unit & 3, g = (unit >> 2) & 7, n = unit >> 5;
    const int fr = lane & 15, fq = lane >> 4;
    const int tok0 = n * 128;
    f32x4 sa[4], sb[4]; u32x4 raw[2][4]; float lg[2], lb[2];
#pragma unroll
    for (int ks = 0; ks < 4; ++ks) { const float* sp = lns + ((size_t)(tok0 + 32 * ks + 8 * fq + (fr & 7)) * 8 + 4 * (fr >> 3)) * 2; sa[ks] = *(const f32x4*)sp; sb[ks] = *(const f32x4*)(sp + 4); }
#pragma unroll
    for (int ct = 0; ct < 2; ++ct) { const int ch = g * 128 + 32 * cq + 16 * ct + fr; lg[ct] = ln_g[ch]; lb[ct] = ln_b[ch];
#pragma unroll
        for (int ks = 0; ks < 4; ++ks) raw[ct][ks] = *(const u32x4*)(VTg + (size_t)ch * T + tok0 + 32 * ks + 8 * fq); }
    const bf16_t* wp0 = wsb + (size_t)(g * 128 + fr) * 128 + 8 * fq;
    const bf16_t* up0 = U + (size_t)(tok0 + fr) * 1024 + g * 128 + 32 * cq + 4 * fq;
    bf16x8 wa[4][4], wb[4][4]; u32x2 ua[4][2], ub[4][2]; float ba[4], bb[4];
#pragma unroll
    for (int pt = 0; pt < 4; ++pt) { ba[pt] = b_s[g * 128 + 16 * pt + fr];
#pragma unroll
        for (int ks = 0; ks < 4; ++ks) wa[pt][ks] = *(const bf16x8*)(wp0 + (size_t)(16 * pt) * 128 + 32 * ks);
#pragma unroll
        for (int ct = 0; ct < 2; ++ct) ua[pt][ct] = *(const u32x2*)(up0 + (size_t)(16 * pt) * 1024 + 16 * ct); }
    SCHED_FENCE();
    bf16x8 af[2][4];
#pragma unroll
    for (int ks = 0; ks < 4; ++ks) {
        float mu[8], rs[8];
        {
            const f32x4 a = sa[ks], b = sb[ks];
            float s = (a[0] + a[2]) + (b[0] + b[2]), q = (a[1] + a[3]) + (b[1] + b[3]);
            s += __shfl_xor(s, 8); q += __shfl_xor(q, 8);
            const float mt = s * (1.0f / 1024.0f), rt = __builtin_amdgcn_rsqf(fmaxf(q * (1.0f / 1024.0f) - mt * mt, 0.f) + LN_EPS);
            const int lb4 = (fq << 4);
#pragma unroll
            for (int j = 0; j < 8; ++j) { mu[j] = __shfl(mt, lb4 | j); rs[j] = __shfl(rt, lb4 | j); }
        }
#pragma unroll
        for (int ct = 0; ct < 2; ++ct) {
            const u32x4 rw = raw[ct][ks];
            float v[8] = {bf_lo(rw.x), bf_hi(rw.x), bf_lo(rw.y), bf_hi(rw.y), bf_lo(rw.z), bf_hi(rw.z), bf_lo(rw.w), bf_hi(rw.w)};
#pragma unroll
            for (int j = 0; j < 8; ++j) v[j] = (v[j] - mu[j]) * rs[j] * lg[ct] + lb[ct];
            u32x4 w; w.x = cvt_pk_bf16(v[0], v[1]); w.y = cvt_pk_bf16(v[2], v[3]); w.z = cvt_pk_bf16(v[4], v[5]); w.w = cvt_pk_bf16(v[6], v[7]);
            af[ct][ks] = __builtin_bit_cast(bf16x8, w);
        }
    }
    SCHED_FENCE();
#pragma unroll
    for (int pt = 0; pt < 4; ++pt) { bb[pt] = b_s[g * 128 + 64 + 16 * pt + fr];
#pragma unroll
        for (int ks = 0; ks < 4; ++ks) wb[pt][ks] = *(const bf16x8*)(wp0 + (size_t)(64 + 16 * pt) * 128 + 32 * ks);
#pragma unroll
        for (int ct = 0; ct < 2; ++ct) ub[pt][ct] = *(const u32x2*)(up0 + (size_t)(64 + 16 * pt) * 1024 + 16 * ct); }
    SCHED_FENCE();
#define GM_HALF(WF, UF, BF, P0) do { _Pragma("unroll") for (int pt = 0; pt < 4; ++pt) { \
        f32x4 a0 = {0.f, 0.f, 0.f, 0.f}, a1 = a0; \
        _Pragma("unroll") for (int ks = 0; ks < 4; ++ks) { a0 = MFMA16(af[0][ks], WF[pt][ks], a0); a1 = MFMA16(af[1][ks], WF[pt][ks], a1); } \
        const float bs = BF[pt]; bf16_t* yp = Y + (size_t)(tok0 + (P0) + 16 * pt + fr) * 2048 + g * 128 + 32 * cq + 4 * fq; \
        _Pragma("unroll") for (int ct = 0; ct < 2; ++ct) { const f32x4 a = ct ? a1 : a0; const u32x2 uw = UF[pt][ct]; \
            u32x2 w; w.x = cvt_pk_bf16(bf_lo(uw.x) * (a[0] + bs), bf_hi(uw.x) * (a[1] + bs)); w.y = cvt_pk_bf16(bf_lo(uw.y) * (a[2] + bs), bf_hi(uw.y) * (a[3] + bs)); \
            *(u32x2*)(yp + 16 * ct) = w; } } } while (0)
    GM_HALF(wa, ua, ba, 0);
    GM_HALF(wb, ub, bb, 64);
#undef GM_HALF
}

__device__ __forceinline__ f32x4 raw4(const bf16_t* p) { const u32x2 w = *(const u32x2*)p; return (f32x4){bf_lo(w.x), bf_hi(w.x), bf_lo(w.y), bf_hi(w.y)}; }
__device__ __forceinline__ void conv_fixup(const bf16_t* RAW, const float* ck, const float* cb, bf16_t* ACT, int gtid, int nthr) {
    constexpr int NJ = FF / 4, NTASK = 128 * 2 * NJ;
    for (int task = gtid; task < NTASK; task += nthr) {
        const int j4 = (task % NJ) * 4, rr = task / NJ, grp = rr >> 1, last = rr & 1;
        const int row = grp * 64 + (last ? 63 : 0);
        const f32x4 z = {0.f, 0.f, 0.f, 0.f};
        f32x4 cv[2];
#pragma unroll
        for (int bj = 0; bj < 2; ++bj) {
            const bf16_t* base = RAW + bj * FF + j4;
            f32x4 pv, cur, nv;
            if (!last) { pv = grp > 0 ? raw4(base + (size_t)((grp - 1) * 4 + 3) * NUP) : z; cur = raw4(base + (size_t)(grp * 4 + 0) * NUP); nv = raw4(base + (size_t)(grp * 4 + 1) * NUP); }
            else { pv = raw4(base + (size_t)(grp * 4 + 2) * NUP); cur = raw4(base + (size_t)(grp * 4 + 3) * NUP); nv = grp < 127 ? raw4(base + (size_t)((grp + 1) * 4 + 0) * NUP) : z; }
            cv[bj] = *(const f32x4*)(ck + 0 * NUP + bj * FF + j4) * pv + *(const f32x4*)(ck + 1 * NUP + bj * FF + j4) * cur + *(const f32x4*)(ck + 2 * NUP + bj * FF + j4) * nv + *(const f32x4*)(cb + bj * FF + j4);
        }
        const f32x4 gt = cv[0], vl = cv[1];
        u32x2 w; w.x = cvt_pk_bf16(gt[0] * sigmoid_f(gt[0]) * vl[0], gt[1] * sigmoid_f(gt[1]) * vl[1]); w.y = cvt_pk_bf16(gt[2] * sigmoid_f(gt[2]) * vl[2], gt[3] * sigmoid_f(gt[3]) * vl[3]);
        *(u32x2*)(ACT + (size_t)row * FF + j4) = w;
    }
}

__global__ void __launch_bounds__(NWAVES * 64, 2) mega_fwd(Params p) {
    extern __shared__ __attribute__((aligned(16))) unsigned char lds_raw[];
    cg::grid_group grid = cg::this_grid();
    LAS unsigned char* lds = (LAS unsigned char*)lds_raw;
    const int G = gridDim.x, bx = blockIdx.x;
    const int NGW = G * NWAVES;
    volatile LAS unsigned* xst = (volatile LAS unsigned*)(lds + LDS_BYTES - 64);
    if (threadIdx.x == 0) { xst[0] = 0u; xst[1] = 0u; }
    __syncthreads();
    XcdBarrier xbar = xcd_barrier_post((unsigned*)p.ws, xst);
#define PHASE_IDS int tid = threadIdx.x; asm volatile("" : "+v"(tid)); const int lane = tid & 63, wave = __builtin_amdgcn_readfirstlane(tid >> 6), gw = bx * NWAVES + wave; (void)lane; (void)gw; (void)wave;
#define PHASE_WS unsigned long long wsv_ = (unsigned long long)p.ws; asm volatile("" : "+s"(wsv_)); __attribute__((address_space(1))) unsigned char* ws = (__attribute__((address_space(1))) unsigned char*)wsv_;
#define WSP(type, off) ((type*)(ws + (off)))

    if (gridDim.x > 4096u) GSYNC_CG();
    { PHASE_IDS p0_prologue(p, lds, gw, NGW, wave, lane); }
    GSYNC();

    for (int l = 0; l < DEPTH; ++l) {
        {
            PHASE_WS
            const __attribute__((address_space(1))) unsigned char* wl = ws + OFF_W + (size_t)l * WL_SIZE;
            pg8::Sched<1> S{(const char*)WSP(bf16_t, OFF_XB0), (const char*)(wl + WL_IN), (size_t)256 * D * 2, (size_t)256 * D * 2, NIN / 256, G, bx};
            pg8::EpiIn E{WSP(float, OFF_SSQP) + (size_t)(2 * l) * T * 32, WSP(bf16_t, OFF_U), WSP(bf16_t, OFF_Q), WSP(bf16_t, OFF_K), WSP(bf16_t, OFF_G), WSP(bf16_t, OFF_VTG), WSP(bf16_t, OFF_VTA), WSP(float, OFF_LNSP) + (size_t)l * T * 16};
            pg8::gemm_phase<pg8::EpiIn, pg8::Sched<1>, true, true>(lds, D, D / 64, S, E);
            {
                PHASE_IDS int idx, cnt; idle_workers(32 * (NIN / 256), G, bx, idx, cnt);
                if (idx >= 0) convert_range(p, lds, l == 0 ? CV_P0 : CV_B, l == 0 ? CV_A : CV_C, idx * NWAVES + wave, cnt * NWAVES, wave, lane);
            }
        }
        GSYNC();
        {
            PHASE_IDS PHASE_WS
            const float* rpb = p.in[7] + (size_t)l * 16 * 465;
            const bf16_t* wsb = WSP(bf16_t, OFF_WSB) + (size_t)l * 8 * 128 * 128;
            if ((bx >> 3) & 1) {
                for (int u = gw; u < 2048; u += NGW) gmlp_unit(WSP(bf16_t, OFF_VTG), WSP(float, OFF_LNSP) + (size_t)l * T * 16, p.in[3] + l * 1024, p.in[4] + l * 1024, wsb, p.in[6] + l * 1024, WSP(bf16_t, OFF_U), WSP(bf16_t, OFF_Y), u, lane);
                __syncthreads();
            }
            attn_phase(WSP(bf16_t, OFF_Q), WSP(bf16_t, OFF_K), WSP(bf16_t, OFF_VTA), rpb, WSP(bf16_t, OFF_Y), lds, bx, G, tid, wave, lane);
            if (!((bx >> 3) & 1)) {
                for (int u = gw; u < 2048; u += NGW) gmlp_unit(WSP(bf16_t, OFF_VTG), WSP(float, OFF_LNSP) + (size_t)l * T * 16, p.in[3] + l * 1024, p.in[4] + l * 1024, wsb, p.in[6] + l * 1024, WSP(bf16_t, OFF_U), WSP(bf16_t, OFF_Y), u, lane);
            }
        }
        GSYNC();
        {
            PHASE_WS
            const __attribute__((address_space(1))) unsigned char* wl = ws + OFF_W + (size_t)l * WL_SIZE;
            pg8::Sched<2> S{(const char*)WSP(bf16_t, OFF_Y), (const char*)(wl + WL_BR), (size_t)256 * D * 2, (size_t)256 * D * 2, D / 256, G, bx};
            pg8::EpiBr E{WSP(bf16_t, OFF_G), WSP(bf16_t, OFF_MG)};
            pg8::gemm_phase<pg8::EpiBr, pg8::Sched<2>, true, true>(lds, D, 1024 / 64, S, E);
        }
        GSYNC();
        {
            PHASE_WS
            const __attribute__((address_space(1))) unsigned char* wl = ws + OFF_W + (size_t)l * WL_SIZE;
            pg8::Sched<0> S{(const char*)WSP(bf16_t, OFF_MG), (const char*)(wl + WL_OUT), (size_t)256 * D * 2, (size_t)256 * D * 2, D / 256, G, bx};
            pg8::EpiRes E{WSP(bf16_t, OFF_XB0), WSP(bf16_t, OFF_XB1), WSP(float, OFF_SSQP) + (size_t)(2 * l + 1) * T * 32};
            pg8::gemm_phase<pg8::EpiRes, pg8::Sched<0>, true, true>(lds, D, D / 64, S, E);
        }
        GSYNC();
        {
            PHASE_WS
            const __attribute__((address_space(1))) unsigned char* wl = ws + OFF_W + (size_t)l * WL_SIZE;
            pg8::Sched<0> S{(const char*)WSP(bf16_t, OFF_XB1), (const char*)(wl + WL_UP), (size_t)256 * D * 2, (size_t)256 * D * 2, NUP / 256, G, bx};
            pg8::EpiUpConv E{WSP(float, OFF_SSQP) + (size_t)(2 * l + 1) * T * 32, p.in[12] + (size_t)l * 3 * NUP, p.in[13] + (size_t)l * NUP, WSP(bf16_t, OFF_ACT), WSP(bf16_t, OFF_RAW)};
            pg8::gemm_phase<pg8::EpiUpConv, pg8::Sched<0>, true, true>(lds, D, D / 64, S, E);
            {
                PHASE_IDS int idx, cnt; idle_workers(32 * (NUP / 256), G, bx, idx, cnt);
                if (idx >= 0) convert_range(p, lds, l == 0 ? CV_A : CV_C, l == 0 ? CV_B : 2 * I_L, idx * NWAVES + wave, cnt * NWAVES, wave, lane);
            }
        }
        GSYNC();
        {
            PHASE_IDS PHASE_WS
            conv_fixup(WSP(bf16_t, OFF_RAW), p.in[12] + (size_t)l * 3 * NUP, p.in[13] + (size_t)l * NUP, WSP(bf16_t, OFF_ACT), bx * (NWAVES * 64) + tid, G * NWAVES * 64);
        }
        GSYNC();
        {
            PHASE_WS
            const __attribute__((address_space(1))) unsigned char* wl = ws + OFF_W + (size_t)l * WL_SIZE;
            pg8::Sched<0> S{(const char*)WSP(bf16_t, OFF_ACT), (const char*)(wl + WL_DN), (size_t)256 * FF * 2, (size_t)256 * FF * 2, D / 256, G, bx};
            pg8::EpiRes E{WSP(bf16_t, OFF_XB1), WSP(bf16_t, OFF_XB0), WSP(float, OFF_SSQP) + (size_t)(2 * l + 2) * T * 32};
            pg8::gemm_phase<pg8::EpiRes, pg8::Sched<0>, true, true>(lds, FF, FF / 64, S, E);
        }
        GSYNC();
    }
    {
        PHASE_IDS PHASE_WS
        const float* gfin = p.in[15]; const float* ssf = WSP(float, OFF_SSQP) + (size_t)4 * T * 32;
        f32x4 gv[8];
#pragma unroll
        for (int j = 0; j < 8; ++j) gv[j] = ((const f32x4*)gfin + lane)[64 * j];
        for (int m = gw; m < T; m += 2 * NGW) {
            const int m2 = m + NGW; const bool two = m2 < T; const int mb = two ? m2 : m;
            const float pa = lane < 32 ? ssf[(size_t)m * 32 + lane] : 0.f, pc = lane < 32 ? ssf[(size_t)mb * 32 + lane] : 0.f;
            const u32x2* xa = (const u32x2*)(WSP(bf16_t, OFF_XB0) + (size_t)m * D) + lane; const u32x2* xc = (const u32x2*)(WSP(bf16_t, OFF_XB0) + (size_t)mb * D) + lane;
            u32x2 wa[8], wc[8];
#pragma unroll
            for (int j = 0; j < 8; ++j) { wa[j] = xa[64 * j]; wc[j] = xc[64 * j]; }
            const float ra = __builtin_amdgcn_rsqf(wave_sum(pa) * (1.0f / D) + RMS_EPS), rc = __builtin_amdgcn_rsqf(wave_sum(pc) * (1.0f / D) + RMS_EPS);
            f32x4* oa = (f32x4*)(p.out + (size_t)m * D) + lane; f32x4* oc = (f32x4*)(p.out + (size_t)m2 * D) + lane;
#pragma unroll
            for (int j = 0; j < 8; ++j) { const u32x2 w = wa[j]; const f32x4 v = {bf_lo(w.x), bf_hi(w.x), bf_lo(w.y), bf_hi(w.y)}; oa[64 * j] = v * ra * gv[j]; }
            if (two) {
#pragma unroll
                for (int j = 0; j < 8; ++j) { const u32x2 w = wc[j]; const f32x4 v = {bf_lo(w.x), bf_hi(w.x), bf_lo(w.y), bf_hi(w.y)}; oc[64 * j] = v * rc * gv[j]; }
            }
        }
    }
}

extern "C" void kernel_launch(void* const* d_in, const int* in_sizes, int n_in, void* d_out, int out_size, void* d_ws, size_t ws_size, hipStream_t stream) {
    static int grid_blocks = 0;
    if (grid_blocks == 0) {
        if (n_in != 16 || out_size != T * D || ws_size < WS_END) { fprintf(stderr, "kernel_launch: unexpected shapes (n_in %d out %d ws %zu)\n", n_in, out_size, ws_size); grid_blocks = -1; return; }
        int dev = 0, cus = 0, per_cu = 0;
        hipGetDevice(&dev);
        hipDeviceGetAttribute(&cus, hipDeviceAttributeMultiprocessorCount, dev);
        hipFuncSetAttribute((const void*)mega_fwd, hipFuncAttributeMaxDynamicSharedMemorySize, LDS_BYTES);
        hipOccupancyMaxActiveBlocksPerMultiprocessor(&per_cu, (const void*)mega_fwd, NWAVES * 64, LDS_BYTES);
        if (per_cu < 1) { fprintf(stderr, "kernel_launch: occupancy query says %d blocks per CU\n", per_cu); per_cu = 1; }
        (void)hipGetLastError();
        grid_blocks = cus * per_cu;
    }
    if (grid_blocks < 0) return;
    Params p{};
    for (int i = 0; i < 16; ++i) p.in[i] = (const float*)d_in[i];
    p.out = (float*)d_out; p.ws = (unsigned char*)d_ws;
    if (hipMemsetAsync(d_ws, 0, 16384, stream) != hipSuccess) { fprintf(stderr, "kernel_launch: memset of the barrier words failed\n"); return; }
    void* args[] = {&p};
    hipError_t e = hipLaunchCooperativeKernel((const void*)mega_fwd, dim3(grid_blocks), dim3(NWAVES * 64), args, LDS_BYTES, stream);
    if (e != hipSuccess) fprintf(stderr, "cooperative launch failed: %s (grid %d)\n", hipGetErrorString(e), grid_blocks);
}
```
